# Optimizing an MI355X kernel written in HIP

```python
import jax, jax.numpy as jnp
from jax import lax
import numpy as np

D_MODEL = 1024
BATCH = 4
SEQ = 4096
DEPTH = 4
DEC_BATCH = 32
DEC_SEQ = 8
PAST_LEN = 8192
PAGE_SIZE = 128

N_MIXERS = 2
N_LRU = (DEPTH + 1) // 2
N_ATT = DEPTH // 2
D_RNN = (3 * D_MODEL) // 2
N_BLOCKS = 16
BLOCK_W = D_RNN // N_BLOCKS
CONV_W = 4
LRU_C = 8.0
N_HEADS = 16
HEAD_DIM = D_MODEL // N_HEADS
D_ATT = N_HEADS * HEAD_DIM
WINDOWS = (128, 512, 2048)
DILATIONS = (1, 4, 16)
N_GROUPS = 3
QKV_W = 3 * N_GROUPS * D_ATT
ATT_SCALE = HEAD_DIM ** -0.5
NEG_INF = -1e30
EPS = 1e-6

kernel_name = "hybrid_rglru_dilated_swa_adaln_step"


def rmsnorm(x, g):
    xf = x.astype(jnp.float32)
    y = xf * lax.rsqrt(jnp.mean(xf * xf, axis=-1, keepdims=True) + EPS)
    return (y * g.astype(jnp.float32)).astype(x.dtype)


def adaln(x, c, g, w, b):
    mod = jax.nn.silu(c) @ w + b
    shift, scale, gate = jnp.split(mod[:, None, :], 3, axis=-1)
    return rmsnorm(x, g) * (1 + scale) + shift, gate


def alibi_slopes():
    return 2.0 ** (-8.0 * jnp.arange(1, N_HEADS + 1, dtype=jnp.float32) / N_HEADS)


def lru_branch(h, conv_buf, h0, w_in, conv_w, conv_b, wa, ba, wx, bx, lam, w_out):
    B, T, _ = h.shape
    xb, gb = jnp.split(h @ w_in, 2, axis=-1)
    xpad = jnp.concatenate([conv_buf.astype(xb.dtype), xb], axis=1)
    xc = conv_b + sum(xpad[:, k:k + T] * conv_w[k] for k in range(CONV_W))
    new_buf = xpad[:, -(CONV_W - 1):]
    xblk = xc.reshape(B, T, N_BLOCKS, BLOCK_W)
    r = jax.nn.sigmoid(jnp.einsum('btni,nij->btnj', xblk, wa).reshape(B, T, D_RNN).astype(jnp.float32) + ba.astype(jnp.float32))
    ig = jax.nn.sigmoid(jnp.einsum('btni,nij->btnj', xblk, wx).reshape(B, T, D_RNN).astype(jnp.float32) + bx.astype(jnp.float32))
    log_a = -LRU_C * r * jax.nn.softplus(-lam.astype(jnp.float32))
    a = jnp.exp(log_a)
    u = jnp.sqrt(-jnp.expm1(2.0 * log_a)) * ig * xc.astype(jnp.float32)

    def step(hc, au):
        hc = au[0] * hc + au[1]
        return hc, hc

    hT, hs = lax.scan(step, h0.astype(jnp.float32), (a.transpose(1, 0, 2), u.transpose(1, 0, 2)))
    y = hs.transpose(1, 0, 2).astype(h.dtype) * jax.nn.silu(gb)
    return y @ w_out, new_buf, hT.astype(h0.dtype)


def dilated_attn_prompt(q, k, v, window, dil, slopes):
    B, S, H, hd = q.shape
    n = window // dil
    blk = n
    L = S // dil
    n_chunks = -(-L // blk)
    Lp = n_chunks * blk

    def to_res(t, front, back):
        t = t.reshape(B, L, dil, H, hd).transpose(0, 2, 1, 3, 4)
        return jnp.pad(t, ((0, 0), (0, 0), (front, back), (0, 0), (0, 0)))

    qr = to_res(q, 0, Lp - L).reshape(B, dil, n_chunks, blk, H, hd)
    kr = to_res(k, blk, Lp - L)
    vr = to_res(v, blk, Lp - L)

    def pairs(t):
        return jnp.concatenate([t[:, :, :Lp].reshape(B, dil, n_chunks, blk, H, hd),
                                t[:, :, blk:].reshape(B, dil, n_chunks, blk, H, hd)], axis=3)

    kp, vp = pairs(kr), pairs(vr)
    ii = jnp.arange(blk)[:, None]
    jj = jnp.arange(2 * blk)[None, :]
    diff = ii - jj + blk
    penalty = slopes[:, None, None] * (diff * dil).astype(jnp.float32)
    band = (diff >= 0) & (diff <= n)

    def one_chunk(args):
        qb, kb, vb, c = args
        s = jnp.einsum('brihd,brjhd->brhij', qb, kb).astype(jnp.float32) * ATT_SCALE - penalty
        valid = band & (c * blk - blk + jj >= 0)
        s = jnp.where(valid, s, NEG_INF)
        lse = jax.nn.logsumexp(s, axis=-1)
        p = jnp.exp(s - lse[..., None]).astype(vb.dtype)
        return jnp.einsum('brhij,brjhd->brihd', p, vb), lse

    mv = lambda t: jnp.moveaxis(t, 2, 0)
    o, lse = lax.map(one_chunk, (mv(qr), mv(kp), mv(vp), jnp.arange(n_chunks)))
    o = jnp.moveaxis(o, 0, 2).reshape(B, dil, Lp, H, hd)[:, :, :L]
    o = o.transpose(0, 2, 1, 3, 4).reshape(B, S, H, hd)
    lse = jnp.swapaxes(jnp.moveaxis(lse, 0, 2), -1, -2).reshape(B, dil, Lp, H)[:, :, :L]
    lse = lse.transpose(0, 2, 1, 3).reshape(B, S, H)
    return o, lse


def dilated_attn_sample(q, k_all, v_all, buf_len, window, dil, slopes):
    B, T, H, hd = q.shape
    n = window // dil
    steps = jnp.arange(n + 1)
    idx = buf_len + jnp.arange(T)[:, None] - dil * steps[None, :]
    valid = idx >= 0
    idx = jnp.maximum(idx, 0)
    kg = k_all[:, idx]
    vg = v_all[:, idx]
    s = jnp.einsum('bthd,btkhd->bhtk', q, kg).astype(jnp.float32) * ATT_SCALE \
        - slopes[:, None, None] * (dil * steps).astype(jnp.float32)
    s = jnp.where(valid, s, NEG_INF)
    lse = jax.nn.logsumexp(s, axis=-1)
    p = jnp.exp(s - lse[..., None]).astype(vg.dtype)
    o = jnp.einsum('bhtk,btkhd->bthd', p, vg)
    return o, lse.transpose(0, 2, 1)


def att_branch(h, w_in, w_out, bufs, slopes):
    B, T, _ = h.shape
    proj = h @ w_in
    qkv = proj[..., :QKV_W].reshape(B, T, N_GROUPS, 3, N_HEADS, HEAD_DIM)
    gate = proj[..., QKV_W:]
    outs, lses, new_kv = [], [], []
    for g in range(N_GROUPS):
        q, k, v = qkv[:, :, g, 0], qkv[:, :, g, 1], qkv[:, :, g, 2]
        if bufs is None:
            o, lse = dilated_attn_prompt(q, k, v, WINDOWS[g], DILATIONS[g], slopes)
            new_kv.append(jnp.stack([k, v], axis=2)[:, T - min(WINDOWS[g], T):])
        else:
            buf = bufs[g].astype(k.dtype)
            k_all = jnp.concatenate([buf[:, :, 0], k], axis=1)
            v_all = jnp.concatenate([buf[:, :, 1], v], axis=1)
            o, lse = dilated_attn_sample(q, k_all, v_all, buf.shape[1], WINDOWS[g], DILATIONS[g], slopes)
            new_kv.append(jnp.stack([k, v], axis=2))
        outs.append(o)
        lses.append(lse)
    wgt = jax.nn.softmax(jnp.stack(lses, axis=0), axis=0)
    o = jnp.einsum('gbth,gbthd->bthd', wgt, jnp.stack(outs, axis=0).astype(jnp.float32))
    y = o.reshape(B, T, D_ATT).astype(h.dtype) * jax.nn.silu(gate)
    return y @ w_out, new_kv


def setup_inputs(seed: int = 0) -> dict:
    key = jax.random.key(seed)
    ks = jax.random.split(key, 32)
    nrm = lambda k, shape, s: jax.random.normal(k, shape, jnp.float32) * s
    buf_lens = [min(w, PAST_LEN) for w in WINDOWS]
    lam = jax.random.uniform(ks[20], (N_LRU, D_RNN), jnp.float32, 0.9, 0.999)
    return {
        "x_prompt": nrm(ks[0], (BATCH, SEQ, D_MODEL), 1.0),
        "x_sample": nrm(ks[1], (DEC_BATCH, DEC_SEQ, D_MODEL), 1.0),
        "state_conv": nrm(ks[2], (N_LRU, DEC_BATCH, CONV_W - 1, D_RNN), 0.5),
        "state_h": nrm(ks[3], (N_LRU, DEC_BATCH, D_RNN), 0.5),
        "cache_kv_g0": nrm(ks[4], (N_ATT, DEC_BATCH, buf_lens[0], 2, N_HEADS, HEAD_DIM), 1.0),
        "cache_kv_g1": nrm(ks[5], (N_ATT, DEC_BATCH, buf_lens[1], 2, N_HEADS, HEAD_DIM), 1.0),
        "cache_kv_g2": nrm(ks[6], (N_ATT, DEC_BATCH, buf_lens[2], 2, N_HEADS, HEAD_DIM), 1.0),
        "c_prompt": nrm(ks[7], (BATCH, D_MODEL), 1.0),
        "c_sample": nrm(ks[8], (DEC_BATCH, D_MODEL), 1.0),
        "norm_g": 1.0 + nrm(ks[9], (DEPTH, D_MODEL), 0.02),
        "ada_w": nrm(ks[10], (DEPTH, D_MODEL, 3 * D_MODEL), 0.3 * D_MODEL ** -0.5),
        "ada_b": nrm(ks[11], (DEPTH, 3 * D_MODEL), 0.02),
        "final_g": 1.0 + nrm(ks[12], (D_MODEL,), 0.02),
        "lru_w_in": nrm(ks[13], (N_LRU, D_MODEL, 2 * D_RNN), D_MODEL ** -0.5),
        "lru_conv_w": nrm(ks[14], (N_LRU, CONV_W, D_RNN), CONV_W ** -0.5),
        "lru_conv_b": nrm(ks[15], (N_LRU, D_RNN), 0.02),
        "lru_wa": nrm(ks[16], (N_LRU, N_BLOCKS, BLOCK_W, BLOCK_W), BLOCK_W ** -0.5),
        "lru_ba": nrm(ks[17], (N_LRU, D_RNN), 0.02),
        "lru_wx": nrm(ks[18], (N_LRU, N_BLOCKS, BLOCK_W, BLOCK_W), BLOCK_W ** -0.5),
        "lru_bx": nrm(ks[19], (N_LRU, D_RNN), 0.02),
        "lru_lambda": jnp.log(lam) - jnp.log1p(-lam),
        "lru_w_out": nrm(ks[21], (N_LRU, D_RNN, D_MODEL), D_RNN ** -0.5),
        "att_w_in": nrm(ks[22], (N_ATT, D_MODEL, QKV_W + D_ATT), D_MODEL ** -0.5),
        "att_w_out": nrm(ks[23], (N_ATT, D_ATT, D_MODEL), D_ATT ** -0.5),
    }


def reference(x_prompt, x_sample, state_conv, state_h, cache_kv_g0, cache_kv_g1, cache_kv_g2,
              c_prompt, c_sample, norm_g, ada_w, ada_b, final_g,
              lru_w_in, lru_conv_w, lru_conv_b, lru_wa, lru_ba, lru_wx, lru_bx, lru_lambda, lru_w_out,
              att_w_in, att_w_out):
    slopes = alibi_slopes()
    yp, ys = x_prompt, x_sample
    Bp = x_prompt.shape[0]
    p_conv, p_h, s_conv, s_h = [], [], [], []
    p_kv = [[] for _ in range(N_GROUPS)]
    s_kv = [[] for _ in range(N_GROUPS)]
    for i in range(DEPTH):
        hp, gp = adaln(yp, c_prompt, norm_g[i], ada_w[i], ada_b[i])
        hs, gs = adaln(ys, c_sample, norm_g[i], ada_w[i], ada_b[i])
        j = i // N_MIXERS
        if i % N_MIXERS == 0:
            prm = (lru_w_in[j], lru_conv_w[j], lru_conv_b[j], lru_wa[j], lru_ba[j],
                   lru_wx[j], lru_bx[j], lru_lambda[j], lru_w_out[j])
            zbuf = jnp.zeros((Bp, CONV_W - 1, D_RNN), x_prompt.dtype)
            zh = jnp.zeros((Bp, D_RNN), x_prompt.dtype)
            op, bp, hTp = lru_branch(hp, zbuf, zh, *prm)
            os_, bs, hTs = lru_branch(hs, state_conv[j], state_h[j], *prm)
            p_conv.append(bp); p_h.append(hTp); s_conv.append(bs); s_h.append(hTs)
        else:
            op, kvp = att_branch(hp, att_w_in[j], att_w_out[j], None, slopes)
            os_, kvs = att_branch(hs, att_w_in[j], att_w_out[j],
                                  (cache_kv_g0[j], cache_kv_g1[j], cache_kv_g2[j]), slopes)
            for g in range(N_GROUPS):
                p_kv[g].append(kvp[g]); s_kv[g].append(kvs[g])
        yp = yp + gp * op
        ys = ys + gs * os_
    y_prompt = rmsnorm(yp, final_g)
    y_sample = rmsnorm(ys, final_g)
    return (y_prompt, y_sample,
            jnp.stack(p_conv), jnp.stack(p_h),
            jnp.stack(p_kv[0]), jnp.stack(p_kv[1]), jnp.stack(p_kv[2]),
            jnp.stack(s_conv), jnp.stack(s_h),
            jnp.stack(s_kv[0]), jnp.stack(s_kv[1]), jnp.stack(s_kv[2]))
```

```cpp
#include <hip/hip_runtime.h>
#include <cstdio>
#include <cstdint>
#define MK_PER_PHASE 0
namespace pg8 {
#define PG8_LAS __attribute__((address_space(3)))
typedef unsigned short bf16_t;
typedef short bf16x8 __attribute__((ext_vector_type(8)));
typedef float f32x4 __attribute__((ext_vector_type(4)));
typedef unsigned u32x4 __attribute__((ext_vector_type(4)));
constexpr int BM = 256, BK = 64, HALF = 128, HTB = HALF * BK * 2  , STAGE_BYTES = 8 * HTB, NXCD = 8, WGM = 4;

__host__ __device__ __forceinline__ int lds_byte(int r, int c) { const int st = (r >> 4) * 2 + (c >> 5), rr = r & 15, cc = c & 31, ob = rr * 64 + cc * 2; return st * 1024 + (ob ^ (((ob >> 9) & 1) << 5)); }
__host__ __device__ __forceinline__ void stage_rc(int b, int& R, int& C) { const int st = b / 1024, sb = b % 1024, swz = sb ^ (((sb >> 9) & 1) << 5); R = (st >> 1) * 16 + swz / 64; C = (st & 1) * 32 + (swz % 64) / 2; }
__host__ __device__ __forceinline__ int perm32(int rho) { const int n = rho >> 4, i = rho & 15; return 8 * (i >> 2) + 4 * n + (i & 3); }

struct Unit { int pm, pn; };
struct Gemm { const bf16_t* A; const bf16_t* Bt; int M, N, K; };

struct StaticOrder {
    int nM, nN, nwg, G, c, rot;
    __host__ __device__ void init(int M, int N, int G_, int c_, int rot_ = 0) { nM = M / BM; nN = N / BM; nwg = nM * nN; G = G_; c = c_; rot = rot_; }
    __host__ __device__ bool next(int i, Unit& u) const {
        const long L = (long)i * G + c; if (L >= nwg) return false;
        int wgid = (int)L; { const int q = nwg / NXCD, r = nwg % NXCD, xcd = wgid % NXCD, off = wgid / NXCD; wgid = (xcd < r ? xcd * (q + 1) : r * (q + 1) + (xcd - r) * q) + off; }
        const int nig = WGM * nN, gid = wgid / nig, fm = gid * WGM, gsz = (nM - fm) < WGM ? (nM - fm) : WGM;
        u.pm = fm + ((wgid % nig) % gsz); u.pn = (wgid % nig) / gsz + rot; if (u.pn >= nN) u.pn -= nN; return true;
    }
    __device__ __forceinline__ void a_ready(const Unit&) const {}
    __device__ __forceinline__ void done(const Unit&) const {}
};

__device__ __forceinline__ unsigned cvt_pk_bf16(float lo, float hi) { unsigned r; asm volatile("v_cvt_pk_bf16_f32 %0, %1, %2" : "=v"(r) : "v"(lo), "v"(hi)); return r; }
typedef float f32x2 __attribute__((ext_vector_type(2)));
__device__ __forceinline__ f32x2 gelu_pk(f32x2 v) {
    const f32x2 av = __builtin_elementwise_abs(v), d = av * 0.2316418882f + 1.0f;
    f32x2 t; t.x = __builtin_amdgcn_rcpf(d.x); t.y = __builtin_amdgcn_rcpf(d.y);
    f32x2 q = t * 0.5307027145f + (-0.7265760135f); q = q * t + 0.7107068705f; q = q * t + (-0.142248368f); q = q * t + 0.127414796f; q = q * t;
    const f32x2 s = (v * v) * (-0.72134752044f);
    f32x2 e; e.x = __builtin_amdgcn_exp2f(s.x); e.y = __builtin_amdgcn_exp2f(s.y);
    const f32x2 m = v * (q * e), r = v - m;
    f32x2 o; o.x = v.x < 0.f ? m.x : r.x; o.y = v.y < 0.f ? m.y : r.y; return o;
}

template <int ACT  > struct EpiBf16 {
    static constexpr bool PERM = true, AFTER_DRAIN = false, PREFETCH = false; static_assert(ACT == 0 || ACT == 1, "EpiBf16: ACT is 0 (none) or 1 (gelu_pk)");
    bf16_t* O; int ldc; const float* bias; int split_cols; size_t split_stride; float scale0;
    __device__ __forceinline__ void operator()(const f32x4 (&acc)[2][2][4][2], const Unit& u, int wr, int wc, int fr, int fq) const {
        const int row0 = u.pm * BM + wr * 64 + fr; int colt = u.pn * BM; bf16_t* base = O;
        float sc = 1.f; if (split_cols) { const int t = colt / split_cols; base += (size_t)t * split_stride; colt -= t * split_cols; if (t == 0) sc = scale0; }
        const int col0 = colt + wc * 32 + 8 * fq, bcol0 = u.pn * BM + wc * 32 + 8 * fq;
        f32x4 bv[2][2];
#pragma unroll
        for (int bj = 0; bj < 2; ++bj)
#pragma unroll
            for (int n = 0; n < 2; ++n) bv[bj][n] = bias ? *(const f32x4*)(bias + bcol0 + bj * HALF + 4 * n) : (f32x4){0.f, 0.f, 0.f, 0.f};
#pragma unroll
        for (int ai = 0; ai < 2; ++ai)
#pragma unroll
            for (int m = 0; m < 4; ++m) { bf16_t* rowp = base + (size_t)(row0 + ai * HALF + m * 16) * ldc + col0;
#pragma unroll
                for (int bj = 0; bj < 2; ++bj) { f32x4 v0 = acc[ai][bj][m][0] + bv[bj][0], v1 = acc[ai][bj][m][1] + bv[bj][1];
                    if (ACT == 1) { f32x2 a = gelu_pk((f32x2){v0[0], v0[1]}), b = gelu_pk((f32x2){v0[2], v0[3]}), c = gelu_pk((f32x2){v1[0], v1[1]}), d = gelu_pk((f32x2){v1[2], v1[3]});
                        v0 = (f32x4){a.x, a.y, b.x, b.y}; v1 = (f32x4){c.x, c.y, d.x, d.y}; }
                    v0 = v0 * sc; v1 = v1 * sc; u32x4 w; w.x = cvt_pk_bf16(v0[0], v0[1]); w.y = cvt_pk_bf16(v0[2], v0[3]); w.z = cvt_pk_bf16(v1[0], v1[1]); w.w = cvt_pk_bf16(v1[2], v1[3]);
                    *(u32x4*)(rowp + bj * HALF) = w; } }
    }
};
template <class Epi, class Sched, bool ALIGN_EPI = false, bool SP2 = false>
__device__ __forceinline__ void gemm_phase(PG8_LAS unsigned char* lds, const Gemm g, const Sched& S, const Epi& E) {
    int tid_ = threadIdx.x; asm volatile("" : "+v"(tid_));
    const int tid = tid_, wid = __builtin_amdgcn_readfirstlane(tid >> 6), lane = tid & 63, wr = wid >> 2, wc = wid & 3, fr = lane & 15, fq = lane >> 4;
    const int K = g.K, nt = K / BK;
    unsigned voffA[2], voffB[2];
#pragma unroll
    for (int i = 0; i < 2; ++i) { int R, C; stage_rc(tid * 16 + i * 8192, R, C); const int Rb = Epi::PERM ? ((R & ~31) + perm32(R & 31)) : R;
        voffA[i] = (unsigned)(R * K + C) * 2u; voffB[i] = (unsigned)(Rb * K + C) * 2u; }
    const size_t kstep = (size_t)(BK * 2);
    const size_t hstep = (size_t)HALF * K * 2;
    const size_t tstep = 2 * hstep;
    const unsigned ldsw = (unsigned)wid * 1024u;
    const int aoff = lds_byte(wr * 64 + fr, fq * 8), boff = lds_byte(wc * 32 + fr, fq * 8);
#define PG8_SA(b, h) (((b) * 2 + (h)) * HTB)
#define PG8_SB(b, h) ((4 + (b) * 2 + (h)) * HTB)
#define PG8_STAGE(bufoff, gbase, voff) do { _Pragma("unroll") for (int _i = 0; _i < 2; ++_i) \
        __builtin_amdgcn_global_load_lds((const unsigned*)((const char*)(gbase) + (voff)[_i]), (PG8_LAS unsigned*)(lds + (bufoff) + ldsw + _i * 8192), 16, 0, 0); } while (0)
#define PG8_LDA(dst, b, h) do { _Pragma("unroll") for (int m = 0; m < 4; ++m) _Pragma("unroll") for (int k = 0; k < 2; ++k) dst[m][k] = *(const PG8_LAS bf16x8*)(lds + PG8_SA(b, h) + aoff + m * 2048 + k * 1024); } while (0)
#define PG8_LDB(dst, b, h) do { _Pragma("unroll") for (int n = 0; n < 2; ++n) _Pragma("unroll") for (int k = 0; k < 2; ++k) dst[n][k] = *(const PG8_LAS bf16x8*)(lds + PG8_SB(b, h) + boff + n * 2048 + k * 1024); } while (0)
#define PG8_MMA(ai, bj, At, Bt) do { __builtin_amdgcn_s_setprio(1); _Pragma("unroll") for (int m = 0; m < 4; ++m) _Pragma("unroll") for (int n = 0; n < 2; ++n) _Pragma("unroll") for (int k = 0; k < 2; ++k) \
        acc[ai][bj][m][n] = __builtin_amdgcn_mfma_f32_16x16x32_bf16(Bt[n][k], At[m][k], acc[ai][bj][m][n], 0, 0, 0); __builtin_amdgcn_s_setprio(0); } while (0)
#define PG8_WAIT_V(n) asm volatile("s_waitcnt vmcnt(" #n ")" ::: "memory")
#define PG8_WAIT_L(n) asm volatile("s_waitcnt lgkmcnt(" #n ")" ::: "memory")
#define PG8_BAR __builtin_amdgcn_s_barrier()
#define PG8_SCHED __builtin_amdgcn_sched_barrier(0)
    Unit cur, nxt; int ui = 0;
    if (!S.next(0, cur)) return;
    f32x4 acc[2][2][4][2];
#pragma unroll
    for (int a = 0; a < 2; ++a)
#pragma unroll
        for (int b = 0; b < 2; ++b)
#pragma unroll
            for (int m = 0; m < 4; ++m)
#pragma unroll
                for (int n = 0; n < 2; ++n) acc[a][b][m][n] = (f32x4){0.f, 0.f, 0.f, 0.f};
    bf16x8 At[4][2], B0[2][2], B1[2][2];
    const char* cA = (const char*)g.A + (size_t)cur.pm * tstep; const char* cB = (const char*)g.Bt + (size_t)cur.pn * tstep;
    S.a_ready(cur);
    if constexpr (SP2) {
        PG8_STAGE(PG8_SB(0, 0), cB, voffB); PG8_STAGE(PG8_SB(0, 1), cB + hstep, voffB); PG8_STAGE(PG8_SA(0, 0), cA, voffA); PG8_STAGE(PG8_SA(0, 1), cA + hstep, voffA);
        if (wr == 1) PG8_BAR;
        PG8_WAIT_V(2); PG8_BAR;
        PG8_STAGE(PG8_SB(1, 0), cB + kstep, voffB); PG8_STAGE(PG8_SA(1, 0), cA + kstep, voffA); PG8_STAGE(PG8_SB(1, 1), cB + hstep + kstep, voffB);
        PG8_WAIT_V(6); PG8_BAR;
    } else {
        PG8_STAGE(PG8_SB(0, 0), cB, voffB); PG8_STAGE(PG8_SA(0, 0), cA, voffA); PG8_STAGE(PG8_SB(0, 1), cB + hstep, voffB); PG8_STAGE(PG8_SA(0, 1), cA + hstep, voffA);
        if (wr == 1) PG8_BAR;
        PG8_WAIT_V(4); PG8_BAR;
        PG8_STAGE(PG8_SB(1, 0), cB + kstep, voffB); PG8_STAGE(PG8_SA(1, 0), cA + kstep, voffA); PG8_STAGE(PG8_SB(1, 1), cB + hstep + kstep, voffB);
        PG8_WAIT_V(6); PG8_BAR;
    }
    for (;;) {
        const bool has_next = S.next(ui + 1, nxt);
        const char* nA = has_next ? (const char*)g.A + (size_t)nxt.pm * tstep : cA; const char* nB = has_next ? (const char*)g.Bt + (size_t)nxt.pn * tstep : cB;
        for (int t = 0; t < nt; t += 2) {
            const bool last = (t == nt - 2);
            const char* a1 = cA + (size_t)(t + 1) * kstep;
            const char* a2 = last ? nA : cA + (size_t)(t + 2) * kstep; const char* b2 = last ? nB : cB + (size_t)(t + 2) * kstep;
            const char* a3 = a2 + kstep; const char* b3 = b2 + kstep;
            if constexpr (Epi::PREFETCH) { if (t < 16) E.prefetch(cur, t >> 1, wid, wr, wc, lane); }
            if (last && has_next) S.a_ready(nxt);
            if constexpr (SP2) {
            PG8_LDB(B0, 0, 0); PG8_LDB(B1, 0, 1); PG8_SCHED; PG8_LDA(At, 0, 0); PG8_STAGE(PG8_SA(1, 1), a1 + hstep, voffA);
            PG8_WAIT_V(8); PG8_WAIT_L(0); PG8_BAR; PG8_MMA(0, 0, At, B0); PG8_MMA(0, 1, At, B1); PG8_BAR; PG8_SCHED;
            PG8_LDA(At, 0, 1); PG8_STAGE(PG8_SB(0, 0), b2, voffB); PG8_STAGE(PG8_SB(0, 1), b2 + hstep, voffB); PG8_STAGE(PG8_SA(0, 0), a2, voffA);
            PG8_WAIT_V(8); PG8_WAIT_L(0); PG8_BAR; PG8_MMA(1, 0, At, B0); PG8_MMA(1, 1, At, B1); PG8_BAR; PG8_SCHED;
            PG8_LDB(B0, 1, 0); PG8_LDB(B1, 1, 1); PG8_SCHED; PG8_LDA(At, 1, 0); PG8_STAGE(PG8_SA(0, 1), a2 + hstep, voffA);
            PG8_WAIT_V(8); PG8_WAIT_L(0); PG8_BAR; PG8_MMA(0, 0, At, B0); PG8_MMA(0, 1, At, B1); PG8_BAR; PG8_SCHED;
            PG8_LDA(At, 1, 1); PG8_STAGE(PG8_SB(1, 0), b3, voffB); PG8_STAGE(PG8_SB(1, 1), b3 + hstep, voffB); PG8_STAGE(PG8_SA(1, 0), a3, voffA);
            PG8_WAIT_V(8); PG8_WAIT_L(0); PG8_BAR; PG8_MMA(1, 0, At, B0); PG8_MMA(1, 1, At, B1); PG8_BAR; PG8_SCHED;
            } else {
            PG8_LDB(B0, 0, 0); PG8_SCHED; PG8_LDA(At, 0, 0); PG8_STAGE(PG8_SA(1, 1), a1 + hstep, voffA);
            PG8_WAIT_L(8); PG8_BAR; PG8_WAIT_L(0); PG8_MMA(0, 0, At, B0); PG8_BAR; PG8_SCHED;
            PG8_LDB(B1, 0, 1); PG8_STAGE(PG8_SB(0, 0), b2, voffB);
            PG8_BAR; PG8_WAIT_L(0); PG8_MMA(0, 1, At, B1); PG8_BAR;
            PG8_LDA(At, 0, 1); PG8_STAGE(PG8_SA(0, 0), a2, voffA);
            PG8_BAR; PG8_WAIT_L(0); PG8_MMA(1, 0, At, B0); PG8_BAR; PG8_SCHED;
            PG8_STAGE(PG8_SB(0, 1), b2 + hstep, voffB);
            PG8_WAIT_V(6); PG8_BAR; PG8_MMA(1, 1, At, B1); PG8_BAR;
            PG8_LDB(B0, 1, 0); PG8_SCHED; PG8_LDA(At, 1, 0); PG8_STAGE(PG8_SA(0, 1), a2 + hstep, voffA);
            PG8_WAIT_L(8); PG8_BAR; PG8_WAIT_L(0); PG8_MMA(0, 0, At, B0); PG8_BAR; PG8_SCHED;
            PG8_LDB(B1, 1, 1); PG8_STAGE(PG8_SB(1, 0), b3, voffB);
            PG8_BAR; PG8_WAIT_L(0); PG8_MMA(0, 1, At, B1); PG8_BAR;
            PG8_LDA(At, 1, 1); PG8_STAGE(PG8_SA(1, 0), a3, voffA);
            PG8_BAR; PG8_WAIT_L(0); PG8_MMA(1, 0, At, B0); PG8_BAR; PG8_SCHED;
            PG8_STAGE(PG8_SB(1, 1), b3 + hstep, voffB);
            PG8_WAIT_V(6); PG8_BAR; PG8_MMA(1, 1, At, B1); PG8_BAR;
            }
        }
        if constexpr (ALIGN_EPI) { if (wr == 0) PG8_BAR; }
        if constexpr (!Epi::AFTER_DRAIN) { E(acc, cur, wr, wc, fr, fq); S.done(cur); }
        if (!has_next) break;
#pragma unroll
        for (int a = 0; a < 2; ++a)
#pragma unroll
            for (int b = 0; b < 2; ++b)
#pragma unroll
                for (int m = 0; m < 4; ++m)
#pragma unroll
                    for (int n = 0; n < 2; ++n) acc[a][b][m][n] = (f32x4){0.f, 0.f, 0.f, 0.f};
        cur = nxt; cA = nA; cB = nB; ++ui;
        if constexpr (ALIGN_EPI) { if (wr == 1) PG8_BAR; }
    }
    PG8_WAIT_V(0);
    if constexpr (!ALIGN_EPI) { if (wr == 0) PG8_BAR; }
    PG8_BAR;
    if constexpr (Epi::AFTER_DRAIN) { E.fused(acc, cur, wr, wc, fr, fq, lds, wid, lane); S.done(cur); }
#undef PG8_SA
#undef PG8_SB
#undef PG8_STAGE
#undef PG8_LDA
#undef PG8_LDB
#undef PG8_MMA
#undef PG8_WAIT_V
#undef PG8_WAIT_L
#undef PG8_BAR
#undef PG8_SCHED
}
}
#ifndef REPMASK
#define REPMASK 0
#endif
constexpr int NWAVES = 8;
constexpr int D = 1024, MP = 16384, MS = 256, MALL = MP + MS, SEQ = 4096, DR = 1536, NQKVG = 10240;
constexpr float EPS = 1e-6f;
constexpr float LOG2E = 1.4426950408889634f, LN2 = 0.6931471805599453f;
constexpr size_t OFF_YP = 0, OFF_YS = 16777216, OFF_PCONV = 17039360, OFF_PH = 17076224, OFF_PKV0 = 17088512, OFF_PKV1 = 19185664, OFF_PKV2 = 27574272,
                 OFF_SCONV = 61128704, OFF_SH = 61423616, OFF_SKV0 = 61521920, OFF_SKV1 = 62570496, OFF_SKV2 = 63619072, OUT_TOTAL = 64667648;
constexpr size_t MiB = 1u << 20;
constexpr size_t WS_CTL = 0, CTL_ZERO_BYTES = 1 * MiB;
constexpr size_t WS_MOD = 1 * MiB;
constexpr size_t WS_WAT = 3 * MiB, WS_WXT = 4 * MiB;
constexpr size_t WS_AGG = 5 * MiB;
constexpr size_t WS_LSE = 7 * MiB;
constexpr size_t WS_SO = 9 * MiB;
constexpr size_t WS_SLSE = 15 * MiB;
constexpr size_t WS_LWIN = 16 * MiB;
constexpr size_t WS_LWOUT = 28 * MiB;
constexpr size_t WS_AWOUT = 34 * MiB;
constexpr size_t WS_AWIN = 38 * MiB;
constexpr size_t WS_X = 80 * MiB;
constexpr size_t WS_H = 146 * MiB;
constexpr size_t WS_Y = 180 * MiB;
constexpr size_t WS_OACC = 230 * MiB;
constexpr size_t WS_XG = 296 * MiB;
constexpr size_t WS_QS = 616 * MiB;
constexpr size_t WS_SW = 628 * MiB;
constexpr size_t WS_SHB = 636 * MiB;
constexpr size_t CTL_RSS = 524288;
constexpr size_t WS_CARRY = 624 * MiB, CARRY_BYTES = 2 * 64 * 1536 * 16;
#ifndef SEPBUF
#define SEPBUF 0
#endif
constexpr size_t WS_SEP = 700 * MiB;
constexpr size_t WS_END = SEPBUF ? (700 + 1930 + 280) * MiB : 640 * MiB;
constexpr int CW_TMO = 0, CW_BAR = 4096;
constexpr int CW_FIN = 65536, FIN_STRIDE = 32;
constexpr int RING_OFF = 0, RING_BYTES = 131072;
constexpr int LDS_BYTES = 163840;
constexpr int LDSCTL_OFF = LDS_BYTES - 1024, MISC_OFF = LDSCTL_OFF + 320;
constexpr int XPP = 208;
constexpr int ATT_V_OFF = 32768, ATT_VP = 144;

#define GAS __attribute__((address_space(1)))
#define LAS __attribute__((address_space(3)))
typedef unsigned short bf16;
typedef unsigned v4u __attribute__((ext_vector_type(4)));
typedef unsigned v2u __attribute__((ext_vector_type(2)));
typedef float f32x4 __attribute__((ext_vector_type(4)));
typedef float f32x2 __attribute__((ext_vector_type(2)));
typedef short bf16x8 __attribute__((ext_vector_type(8)));
typedef short s16x4 __attribute__((ext_vector_type(4)));
typedef GAS unsigned gu32;
#define RLX_AGENT __ATOMIC_RELAXED, __HIP_MEMORY_SCOPE_AGENT
#define LDS_WAIT() asm volatile("s_waitcnt lgkmcnt(0)" ::: "memory")
typedef float f32x2c_t __attribute__((ext_vector_type(2))); typedef __bf16 bf16x2c_t __attribute__((ext_vector_type(2)));
__device__ __forceinline__ unsigned pk2(float lo, float hi) { const f32x2c_t v = {lo, hi}; const bf16x2c_t b = __builtin_convertvector(v, bf16x2c_t); return __builtin_bit_cast(unsigned, b); }
__device__ __forceinline__ unsigned f2bf(float f) { return pk2(f, 0.f) & 0xffffu; }
__device__ __forceinline__ float bf2f(unsigned b) { return __builtin_bit_cast(float, b << 16); }
__device__ __forceinline__ float bflo(unsigned w) { return __builtin_bit_cast(float, w << 16); }
__device__ __forceinline__ float bfhi(unsigned w) { return __builtin_bit_cast(float, w & 0xffff0000u); }
__device__ __forceinline__ float sigmoid_f(float x) { return __builtin_amdgcn_rcpf(1.f + __builtin_amdgcn_exp2f(-LOG2E * x)); }
__device__ __forceinline__ float silu_f(float x) { return x * sigmoid_f(x); }
#define XB_TMO      128
#define XB_XCNT(j)  (256  + 64 * (j))
#define XB_XSUB(j)  (1280 + 64 * (j))
#define XB_XGEN(j)  (2304 + 64 * (j))
#define XB_TOP      3328
#define XB_TOPGEN   3392
#define XCD_BAR_WORDS 3456
#define XB_SPIN_CAP (1u << 18)

__device__ __forceinline__ unsigned xb_ld(unsigned* p)              { return __hip_atomic_load(p, __ATOMIC_RELAXED, __HIP_MEMORY_SCOPE_AGENT); }
__device__ __forceinline__ unsigned xb_add(unsigned* p, unsigned v) { return __hip_atomic_fetch_add(p, v, __ATOMIC_RELAXED, __HIP_MEMORY_SCOPE_AGENT); }
__device__ __forceinline__ unsigned xb_xcc_id() { return (unsigned)__builtin_amdgcn_s_getreg((3 << 11) | 20) & 0xFu; }
#define XB_SPIN(cond, bar) do { unsigned _sp = 0; while (cond) { __builtin_amdgcn_s_sleep(1); \
    if ((++_sp & 255u) == 0u) { if (xb_ld(&(bar)[XB_TMO])) break; if (_sp > XB_SPIN_CAP) { atomicAdd(&(bar)[XB_TMO], 1u); break; } } } } while (0)

struct XcdBarrier {
    unsigned* bar; unsigned x;
    volatile LAS unsigned* st;
};

__device__ __forceinline__ XcdBarrier xcd_barrier_post(unsigned* bar, volatile LAS unsigned* st) {
    XcdBarrier b; b.bar = bar; b.x = xb_xcc_id(); b.st = st;
    if (threadIdx.x == 0) (void)xb_add(&bar[XB_XCNT(b.x)], 1u);
    return b;
}
__device__ __forceinline__ void xcd_barrier_complete(unsigned* bar, unsigned x, unsigned& nloc, unsigned& nx) {
    const unsigned G = gridDim.x * gridDim.y * gridDim.z;
    unsigned sum, cnt, mine, sp = 0u;
    for (;;) {
        sum = 0u; cnt = 0u; mine = 0u;
#pragma unroll
        for (unsigned j = 0; j < 16; ++j) { const unsigned c = xb_ld(&bar[XB_XCNT(j)]); sum += c; cnt += (c > 0u) ? 1u : 0u; mine = (j == x) ? c : mine; }
        if (sum == G) break;
        __builtin_amdgcn_s_sleep(1);
        if ((++sp & 255u) == 0u) { if (xb_ld(&bar[XB_TMO])) break; if (sp > XB_SPIN_CAP) { atomicAdd(&bar[XB_TMO], 1u); break; } }
    }
    nloc = mine > 0u ? mine : 1u; nx = cnt > 0u ? cnt : 1u;
}

__device__ __forceinline__ void xcd_barrier(const XcdBarrier& b) {
    asm volatile("s_waitcnt vmcnt(0)" ::: "memory");
    __syncthreads();
    if (threadIdx.x == 0) {
        unsigned* bar = b.bar;
        __builtin_amdgcn_s_waitcnt(0);
        unsigned nloc = b.st[0], nx = b.st[1];
        if (nloc == 0u) { xcd_barrier_complete(bar, b.x, nloc, nx); b.st[0] = nloc; b.st[1] = nx; }
        const unsigned old = xb_add(&bar[XB_XSUB(b.x)], 1u);
        const unsigned gen = old / nloc;
        if (old + 1u == (gen + 1u) * nloc) {
            __builtin_amdgcn_fence(__ATOMIC_RELEASE, "agent");
            asm volatile("s_waitcnt vmcnt(0)" ::: "memory");
            const unsigned og = xb_add(&bar[XB_TOP], 1u);
            const unsigned tg = og / nx;
            if (og + 1u == (tg + 1u) * nx) xb_add(&bar[XB_TOPGEN], 1u);
            else XB_SPIN(xb_ld(&bar[XB_TOPGEN]) == tg, bar);
            __builtin_amdgcn_fence(__ATOMIC_ACQUIRE, "agent");
            xb_add(&bar[XB_XGEN(b.x)], 1u);
            asm volatile("s_waitcnt vmcnt(0)" ::: "memory");
        } else {
            XB_SPIN(xb_ld(&bar[XB_XGEN(b.x)]) == gen, bar);
            __builtin_amdgcn_fence(__ATOMIC_ACQUIRE, "agent");
            asm volatile("s_waitcnt vmcnt(0)" ::: "memory");
        }
    }
    __syncthreads();
}
__device__ __forceinline__ const void* launder_ptr(const void* p) {
    unsigned lo = (unsigned)(unsigned long long)p, hi = (unsigned)((unsigned long long)p >> 32);
    asm volatile("" : "+v"(lo), "+v"(hi));
    lo = __builtin_amdgcn_readfirstlane(lo); hi = __builtin_amdgcn_readfirstlane(hi);
    return (const void*)(((unsigned long long)hi << 32) | lo);
}
struct Args { const float* in[24]; float* outp; unsigned char* ws; int ph_lo, ph_hi; };
struct Frame {
    LAS unsigned char* lds;
    volatile LAS unsigned* MISC;
    int tid, vcu, G;
    int sA, sO;
    const __attribute__((address_space(4))) Args* A; unsigned char* ws;
    __device__ __forceinline__ float* out() const { return A->outp; }
    __device__ __forceinline__ gu32* ctl() const { return (gu32*)(ws + WS_CTL); }
    __device__ __forceinline__ const float* x_prompt() const { return A->in[0]; }
    __device__ __forceinline__ const float* x_sample() const { return A->in[1]; }
    __device__ __forceinline__ const float* state_conv() const { return A->in[2]; }
    __device__ __forceinline__ const float* state_h() const { return A->in[3]; }
    __device__ __forceinline__ const float* cache0() const { return A->in[4]; }
    __device__ __forceinline__ const float* cache1() const { return A->in[5]; }
    __device__ __forceinline__ const float* cache2() const { return A->in[6]; }
    __device__ __forceinline__ const float* c_prompt() const { return A->in[7]; }
    __device__ __forceinline__ const float* c_sample() const { return A->in[8]; }
    __device__ __forceinline__ const float* norm_g() const { return A->in[9]; }
    __device__ __forceinline__ const float* ada_w() const { return A->in[10]; }
    __device__ __forceinline__ const float* ada_b() const { return A->in[11]; }
    __device__ __forceinline__ const float* final_g() const { return A->in[12]; }
    __device__ __forceinline__ const float* lru_w_in() const { return A->in[13]; }
    __device__ __forceinline__ const float* lru_conv_w() const { return A->in[14]; }
    __device__ __forceinline__ const float* lru_conv_b() const { return A->in[15]; }
    __device__ __forceinline__ const float* lru_wa() const { return A->in[16]; }
    __device__ __forceinline__ const float* lru_ba() const { return A->in[17]; }
    __device__ __forceinline__ const float* lru_wx() const { return A->in[18]; }
    __device__ __forceinline__ const float* lru_bx() const { return A->in[19]; }
    __device__ __forceinline__ const float* lru_lambda() const { return A->in[20]; }
    __device__ __forceinline__ const float* lru_w_out() const { return A->in[21]; }
    __device__ __forceinline__ const float* att_w_in() const { return A->in[22]; }
    __device__ __forceinline__ const float* att_w_out() const { return A->in[23]; }
    __device__ __forceinline__ float* mod() const { return (float*)(ws + WS_MOD); }
    __device__ __forceinline__ bf16* wa_t() const { return (bf16*)(ws + WS_WAT); }
    __device__ __forceinline__ bf16* wx_t() const { return (bf16*)(ws + WS_WXT); }
    __device__ __forceinline__ f32x2* agg() const { return (f32x2*)(ws + WS_AGG); }
    __device__ __forceinline__ float* lse() const { return (float*)(ws + (SEPBUF ? WS_SEP + 1870 * MiB + (size_t)sO * (2 * MiB) : WS_LSE)); }
    __device__ __forceinline__ bf16* lwin_t() const { return (bf16*)(ws + WS_LWIN); }
    __device__ __forceinline__ bf16* lwout_t() const { return (bf16*)(ws + WS_LWOUT); }
    __device__ __forceinline__ bf16* awin_t() const { return (bf16*)(ws + WS_AWIN); }
    __device__ __forceinline__ bf16* awout_t() const { return (bf16*)(ws + WS_AWOUT); }
    __device__ __forceinline__ bf16* HN() const { return (bf16*)(ws + (SEPBUF ? WS_SEP + (size_t)(sA + 1) * (36 * MiB) : WS_H)); }
    __device__ __forceinline__ float* SW(int layer) const { return (float*)(ws + WS_SW) + (size_t)layer * 36 * 10240; }
    __device__ __forceinline__ bf16* SHB(int layer) const { return (bf16*)(ws + WS_SHB) + (size_t)layer * 256 * 1024; }
    __device__ __forceinline__ float* RSS(int layer) const { return (float*)(ws + WS_CTL + CTL_RSS) + (size_t)layer * MALL; }
    __device__ __forceinline__ unsigned long long* carry() const { return (unsigned long long*)(ws + WS_CARRY); }
    __device__ __forceinline__ float* X() const { return (float*)(ws + WS_X); }
    __device__ __forceinline__ float* XL(int layer) const { return (float*)(ws + (SEPBUF ? WS_SEP + 1930 * MiB + (size_t)layer * (70 * MiB) : WS_X)); }
    __device__ __forceinline__ bf16* H() const { return (bf16*)(ws + (SEPBUF ? WS_SEP + (size_t)sA * (36 * MiB) : WS_H)); }
    __device__ __forceinline__ bf16* Y() const { return (bf16*)(ws + (SEPBUF ? WS_SEP + 1500 * MiB + (size_t)sA * (52 * MiB) : WS_Y)); }
    __device__ __forceinline__ float* OACC() const { return (float*)(ws + (SEPBUF ? WS_SEP + 1720 * MiB + (size_t)sO * (70 * MiB) : WS_OACC)); }
    __device__ __forceinline__ bf16* XG() const { return (bf16*)(ws + (SEPBUF ? WS_SEP + 160 * MiB + (size_t)sA * (330 * MiB) : WS_XG)); }
    __device__ __forceinline__ bf16* QS() const { return (bf16*)(ws + (SEPBUF ? WS_SEP + 1910 * MiB + (size_t)sO * (6 * MiB) : WS_QS)); }
    __device__ __forceinline__ float* SO() const { return (float*)(ws + (SEPBUF ? WS_SEP + 1880 * MiB + (size_t)sO * (8 * MiB) : WS_SO)); }
    __device__ __forceinline__ float* SLSE() const { return (float*)(ws + (SEPBUF ? WS_SEP + 1900 * MiB + (size_t)sO * (1 * MiB) : WS_SLSE)); }
};

__device__ __forceinline__ void glds16(const void* gsrc, unsigned lds_dst) { unsigned keep;
    asm volatile("s_mov_b32 %0, m0\n\ts_mov_b32 m0, %2\n\ts_nop 0\n\tglobal_load_lds_dwordx4 %1, off\n\ts_mov_b32 m0, %0" : "=&s"(keep) : "v"(gsrc), "s"(lds_dst) : "memory"); }
__device__ __forceinline__ float shx(float v, int lane, int k) { return __builtin_bit_cast(float, __builtin_amdgcn_ds_bpermute((lane ^ k) << 2, __builtin_bit_cast(int, v))); }
__device__ __forceinline__ float shup(float v, int lane, int k) { const int src = lane >= k ? lane - k : lane; return __builtin_bit_cast(float, __builtin_amdgcn_ds_bpermute(src << 2, __builtin_bit_cast(int, v))); }
__device__ __forceinline__ float shl(float v, int src) { return __builtin_bit_cast(float, __builtin_amdgcn_ds_bpermute(src << 2, __builtin_bit_cast(int, v))); }
__device__ __forceinline__ float wave_sum(float v, int lane) {
#pragma unroll
    for (int o = 1; o < 64; o <<= 1) v += shx(v, lane, o);
    return v;
}
__device__ __forceinline__ void p0_transpose_item(const float* W, int K, int N, bf16* WT, LAS float* scr, int item, int lane) {
    const int nblk = N / 32, kb = item / nblk, nb = item % nblk, k0 = 64 * kb, n0 = 32 * nb;
    float wv[32];
#pragma unroll
    for (int i = 0; i < 32; ++i) { const int kk = 2 * i + (lane >> 5); wv[i] = W[(size_t)(k0 + kk) * N + n0 + (lane & 31)]; }
#pragma unroll
    for (int i = 0; i < 32; ++i) { const int kk = 2 * i + (lane >> 5); scr[kk * 33 + (lane & 31)] = wv[i]; }
    LDS_WAIT(); asm volatile("" ::: "memory");
    const int c = lane & 7;
#pragma unroll
    for (int j = 0; j < 4; ++j) { const int n = (lane >> 3) + 8 * j; const LAS float* s = scr + (8 * c) * 33 + n;
        v4u o; o.x = pk2(s[0 * 33], s[1 * 33]); o.y = pk2(s[2 * 33], s[3 * 33]); o.z = pk2(s[4 * 33], s[5 * 33]); o.w = pk2(s[6 * 33], s[7 * 33]);
        *(GAS v4u*)(WT + (size_t)(n0 + n) * K + k0 + 8 * c) = o; }
    LDS_WAIT(); asm volatile("" ::: "memory");
}

constexpr int CV_LIN = 16 * 96, CV_LOUT = CV_LIN + 24 * 32, CV_AIN = CV_LOUT + 16 * 320, CV_AOUT = CV_AIN + 16 * 32;
__device__ __forceinline__ void conv_items(Frame& F, int j, int lo, int hi, int rank, int nrank) {
    int tid_ = F.tid; asm volatile("" : "+v"(tid_));
    const int lane = tid_ & 63, wave = __builtin_amdgcn_readfirstlane(tid_ >> 6), wk = rank * NWAVES + wave, nwk = nrank * NWAVES;
    LAS float* scr = (LAS float*)(F.lds + RING_OFF + wave * 16384);
    for (int it = lo + wk; it < hi; it += nwk) {
        if (it < CV_LIN) p0_transpose_item(F.lru_w_in() + (size_t)j * 1024 * 3072, 1024, 3072, F.lwin_t() + (size_t)j * 3072 * 1024, scr, it, lane);
        else if (it < CV_LOUT) p0_transpose_item(F.lru_w_out() + (size_t)j * 1536 * 1024, 1536, 1024, F.lwout_t() + (size_t)j * 1024 * 1536, scr, it - CV_LIN, lane);
        else if (it < CV_AIN) p0_transpose_item(F.att_w_in() + (size_t)j * 1024 * 10240, 1024, 10240, F.awin_t() + (size_t)j * 10240 * 1024, scr, it - CV_LOUT, lane);
        else p0_transpose_item(F.att_w_out() + (size_t)j * 1024 * 1024, 1024, 1024, F.awout_t() + (size_t)j * 1024 * 1024, scr, it - CV_AIN, lane);
    }
}
__device__ __forceinline__ void p0_prologue(Frame& F) {
    LAS float* L = (LAS float*)(F.lds + RING_OFF);
    int tid_ = F.tid; asm volatile("" : "+v"(tid_));
    const int tid = tid_, p_lane = tid & 63, p_wave = __builtin_amdgcn_readfirstlane(tid >> 6);
    for (int u = F.vcu; u < 192; u += F.G) {
        const int layer = u / 48, n0 = (u % 48) * 64, col = tid & 63, kg = tid >> 6;
        float acc[36];
#pragma unroll
        for (int r = 0; r < 36; ++r) acc[r] = 0.f;
        for (int kh = 0; kh < 2; ++kh) {
            __syncthreads();
            { const int k = kh * 512 + tid;
#pragma unroll 4
              for (int r = 0; r < 36; ++r) { const float cv = (r < 4) ? F.c_prompt()[r * 1024 + k] : F.c_sample()[(r - 4) * 1024 + k]; L[tid * 36 + r] = silu_f(cv); } }
            __syncthreads();
            const float* wp = F.ada_w() + ((size_t)layer * 1024 + kh * 512 + kg * 64) * 3072 + n0 + col;
#pragma unroll 2
            for (int kl = 0; kl < 64; ++kl) { const float w = wp[(size_t)kl * 3072]; const LAS f32x4* s4 = (const LAS f32x4*)(L + (kg * 64 + kl) * 36);
#pragma unroll
                for (int q = 0; q < 9; ++q) { const f32x4 s = s4[q]; acc[4 * q] += s.x * w; acc[4 * q + 1] += s.y * w; acc[4 * q + 2] += s.z * w; acc[4 * q + 3] += s.w * w; } }
        }
        __syncthreads();
#pragma unroll
        for (int r = 0; r < 36; ++r) L[(kg * 36 + r) * 64 + col] = acc[r];
        __syncthreads();
        for (int o = tid; o < 36 * 64; o += 512) { const int r = o >> 6, c = o & 63; float s = F.ada_b()[layer * 3072 + n0 + c];
#pragma unroll
            for (int g = 0; g < 8; ++g) s += L[(g * 36 + r) * 64 + c];
            F.mod()[((size_t)layer * 36 + r) * 3072 + n0 + c] = s;
            if (n0 < 1024) F.SHB(layer)[(size_t)r * 1024 + n0 + c] = (bf16)f2bf(s); }
        __syncthreads();
    }
    for (int e = F.vcu * 512 + tid; e < 2 * 16 * 9216; e += F.G * 512) { const int blk = e / 9216, rem = e % 9216, jj = rem / 96, i = rem % 96;
        F.wa_t()[e] = (bf16)f2bf(F.lru_wa()[(size_t)blk * 9216 + i * 96 + jj]); F.wx_t()[e] = (bf16)f2bf(F.lru_wx()[(size_t)blk * 9216 + i * 96 + jj]); }
    conv_items(F, 0, 0, CV_LIN, F.vcu, F.G);
}

__device__ __forceinline__ void norm_phase(Frame& F, int layer) {
    int tid_ = F.tid; asm volatile("" : "+v"(tid_));
    const int lane = tid_ & 63, wave = __builtin_amdgcn_readfirstlane(tid_ >> 6);
    const int gw = F.vcu * NWAVES + wave, NGW = F.G * NWAVES;
    const float* gp = F.norm_g() + layer * 1024; const float* mod = F.mod() + (size_t)layer * 36 * 3072;
    for (int m0 = gw; m0 < MALL; m0 += 2 * NGW) {
        const int m1 = (m0 + NGW < MALL) ? m0 + NGW : m0;
        f32x4 v[2][4];
#pragma unroll
        for (int r = 0; r < 2; ++r) { const int m = r ? m1 : m0; const bool sm = m >= MP;
            const float* xrow = (layer == 0) ? (sm ? F.x_sample() + (size_t)(m - MP) * 1024 : F.x_prompt() + (size_t)m * 1024) : F.XL(layer - 1) + (size_t)m * 1024;
            const GAS f32x4* xr = (const GAS f32x4*)xrow + lane;
#pragma unroll
            for (int q = 0; q < 4; ++q) v[r][q] = xr[64 * q]; }
#pragma unroll
        for (int r = 0; r < 2; ++r) { const int m = r ? m1 : m0; const bool sm = m >= MP; const int mr = sm ? 4 + ((m - MP) >> 3) : (m >> 12);
            float s = 0.f;
#pragma unroll
            for (int q = 0; q < 4; ++q) s += (v[r][q].x * v[r][q].x + v[r][q].y * v[r][q].y) + (v[r][q].z * v[r][q].z + v[r][q].w * v[r][q].w);
            const float rstd = rsqrtf(wave_sum(s, lane) * (1.f / 1024.f) + EPS);
            const float* mrow = mod + (size_t)mr * 3072;
            GAS v2u* o8 = (GAS v2u*)(F.H() + (size_t)m * 1024) + lane;
#pragma unroll
            for (int q = 0; q < 4; ++q) { const int c = 4 * lane + 256 * q;
                const f32x4 g4 = *(const f32x4*)(gp + c), sh = *(const f32x4*)(mrow + c), sc = *(const f32x4*)(mrow + 1024 + c);
                const f32x4 h = v[r][q] * rstd * g4 * (sc + 1.f) + sh;
                v2u w; w.x = pk2(h.x, h.y); w.y = pk2(h.z, h.w); o8[64 * q] = w; } }
    }
}
__device__ __forceinline__ void final_phase(Frame& F) {
    int tid_ = F.tid; asm volatile("" : "+v"(tid_));
    const int lane = tid_ & 63, wave = __builtin_amdgcn_readfirstlane(tid_ >> 6);
    const int gw = F.vcu * NWAVES + wave, NGW = F.G * NWAVES;
    for (int m0 = gw; m0 < MALL; m0 += 2 * NGW) {
        const int m1 = (m0 + NGW < MALL) ? m0 + NGW : m0;
        f32x4 v[2][4];
#pragma unroll
        for (int r = 0; r < 2; ++r) { const GAS f32x4* xr = (const GAS f32x4*)(F.XL(3) + (size_t)(r ? m1 : m0) * 1024) + lane;
#pragma unroll
            for (int q = 0; q < 4; ++q) v[r][q] = xr[64 * q]; }
#pragma unroll
        for (int r = 0; r < 2; ++r) { float s = 0.f;
#pragma unroll
            for (int q = 0; q < 4; ++q) s += (v[r][q].x * v[r][q].x + v[r][q].y * v[r][q].y) + (v[r][q].z * v[r][q].z + v[r][q].w * v[r][q].w);
            const float rstd = rsqrtf(wave_sum(s, lane) * (1.f / 1024.f) + EPS);
            GAS f32x4* o = (GAS f32x4*)(F.out() + (size_t)(r ? m1 : m0) * 1024) + lane;
#pragma unroll
            for (int q = 0; q < 4; ++q) { const f32x4 g4 = *(const f32x4*)(F.final_g() + 4 * lane + 256 * q); o[64 * q] = v[r][q] * rstd * g4; } }
    }
}

namespace pg8 {
constexpr int MPROMPT = 16384;
struct EpiResid {
    static constexpr bool PERM = true, AFTER_DRAIN = false, PREFETCH = true;
    const Frame& F; int l; bool hasnext;
    __device__ __forceinline__ void prefetch(const Unit& u, int i, int wid, int wr, int wc, int lane) const {
        const float* xin = (l == 0) ? F.x_prompt() : F.XL(l - 1);
        const float* base = xin + (size_t)(u.pm * BM + wr * 64 + (i >> 2) * HALF + 16 * (i & 3)) * 1024 + u.pn * BM + wc * 32;
        const unsigned voff = (unsigned)(lane >> 2) * 4096u + (unsigned)((lane >> 1) & 1) * 512u + (unsigned)(lane & 1) * 64u;
        const unsigned dst = (unsigned)(size_t)(F.lds + RING_BYTES) + (unsigned)wid * 1024u; unsigned keep;
        asm volatile("s_mov_b32 %0, m0\n\ts_mov_b32 m0, %3\n\ts_nop 0\n\tglobal_load_lds_dwordx4 %1, %2\n\ts_mov_b32 m0, %0" : "=&s"(keep) : "v"(voff), "s"(base), "s"(dst) : "memory");
    }
    __device__ __forceinline__ void operator()(const f32x4 (&acc)[2][2][4][2], const Unit& u, int wr, int wc, int fr, int fq) const {
        const float* xin = (l == 0) ? F.x_prompt() : F.XL(l - 1); float* xout = F.XL(l); const float* gate = F.mod() + (size_t)l * 36 * 3072 + 2048;
        bf16_t* hn = hasnext ? F.HN() : nullptr; const float* gnext = F.norm_g() + (l + 1) * 1024; const float* scnext = F.mod() + (size_t)(l + 1) * 36 * 3072 + 1024; float* rss = F.RSS(hasnext ? l + 1 : 0);
        const int row0 = u.pm * BM + wr * 64 + fr, col0 = u.pn * BM + wc * 32 + 8 * fq;
        const int mr = row0 >> 12;
        float ss[2][4];
#pragma unroll
        for (int ai = 0; ai < 2; ++ai)
#pragma unroll
            for (int m = 0; m < 4; ++m) ss[ai][m] = 0.f;
#pragma unroll
        for (int bj = 0; bj < 2; ++bj) { const int c = col0 + bj * HALF;
            const f32x4 g0 = *(const f32x4*)(gate + (size_t)mr * 3072 + c), g1 = *(const f32x4*)(gate + (size_t)mr * 3072 + c + 4);
            f32x4 m0 = g0, m1 = g1;
            if (hn) { const f32x4 a0 = *(const f32x4*)(gnext + c), a1 = *(const f32x4*)(gnext + c + 4), s0 = *(const f32x4*)(scnext + (size_t)mr * 3072 + c), s1 = *(const f32x4*)(scnext + (size_t)mr * 3072 + c + 4);
                m0 = a0 * (s0 + 1.f); m1 = a1 * (s1 + 1.f); }
#pragma unroll
            for (int ai = 0; ai < 2; ++ai)
#pragma unroll
              for (int mh = 0; mh < 2; ++mh) {
                f32x4 xo[2][2];
#pragma unroll
                for (int mm = 0; mm < 2; ++mm) { const size_t ro = (size_t)(row0 + ai * HALF + (2 * mh + mm) * 16) * 1024 + c; xo[mm][0] = *(const f32x4*)(xin + ro); xo[mm][1] = *(const f32x4*)(xin + ro + 4); }
#pragma unroll
                for (int mm = 0; mm < 2; ++mm) asm volatile("" : "+v"(xo[mm][0]), "+v"(xo[mm][1]));
#pragma unroll
                for (int mm = 0; mm < 2; ++mm) { const int m = 2 * mh + mm; const size_t ro = (size_t)(row0 + ai * HALF + m * 16) * 1024 + c;
                    const f32x4 x0 = xo[mm][0] + g0 * acc[ai][bj][m][0], x1 = xo[mm][1] + g1 * acc[ai][bj][m][1];
                    *(f32x4*)(xout + ro) = x0; *(f32x4*)(xout + ro + 4) = x1;
                    if (hn) { ss[ai][m] += (x0[0] * x0[0] + x0[1] * x0[1]) + (x0[2] * x0[2] + x0[3] * x0[3]) + (x1[0] * x1[0] + x1[1] * x1[1]) + (x1[2] * x1[2] + x1[3] * x1[3]);
                        const f32x4 h0 = x0 * m0, h1 = x1 * m1;
                        u32x4 w; w.x = cvt_pk_bf16(h0[0], h0[1]); w.y = cvt_pk_bf16(h0[2], h0[3]); w.z = cvt_pk_bf16(h1[0], h1[1]); w.w = cvt_pk_bf16(h1[2], h1[3]);
                        *(u32x4*)(hn + ro) = w; } } } }
        if (hn) {
#pragma unroll
            for (int ai = 0; ai < 2; ++ai)
#pragma unroll
                for (int m = 0; m < 4; ++m) { float v = ss[ai][m]; const int ln = fr + 16 * fq;
                    v += __builtin_bit_cast(float, __builtin_amdgcn_ds_bpermute((ln ^ 16) << 2, __builtin_bit_cast(int, v))); v += __builtin_bit_cast(float, __builtin_amdgcn_ds_bpermute((ln ^ 32) << 2, __builtin_bit_cast(int, v)));
                    if (fq == 0) atomicAdd(rss + row0 + ai * HALF + m * 16, v); } }
    }
};
struct EpiFinal {
    static constexpr bool PERM = true, AFTER_DRAIN = true, PREFETCH = true;
    const Frame& F; int l;
    __device__ __forceinline__ void prefetch(const Unit& u, int i, int wid, int wr, int wc, int lane) const {
        const float* xin = F.XL(l - 1);
        const float* base = xin + (size_t)(u.pm * BM + wr * 64 + (i >> 2) * HALF + 16 * (i & 3)) * 1024 + u.pn * BM + wc * 32;
        const unsigned voff = (unsigned)(lane >> 2) * 4096u + (unsigned)((lane >> 1) & 1) * 512u + (unsigned)(lane & 1) * 64u;
        const unsigned dst = (unsigned)(size_t)(F.lds + RING_BYTES) + (unsigned)wid * 1024u; unsigned keep;
        asm volatile("s_mov_b32 %0, m0\n\ts_mov_b32 m0, %3\n\ts_nop 0\n\tglobal_load_lds_dwordx4 %1, %2\n\ts_mov_b32 m0, %0" : "=&s"(keep) : "v"(voff), "s"(base), "s"(dst) : "memory");
    }
    template <class L> __device__ __forceinline__ void fused(f32x4 (&acc)[2][2][4][2], const Unit& u, int wr, int wc, int fr, int fq, L lds, int wid, int lane) const {
        const LAS unsigned char* park = (const LAS unsigned char*)lds + (unsigned)(wid * 64 + lane) * 16u;
        const float* xin = F.XL(l - 1); const float* gate = F.mod() + (size_t)l * 36 * 3072 + 2048; float* rss = F.RSS(0);
        int row0 = u.pm * BM + wr * 64 + fr, col0 = u.pn * BM + wc * 32 + 8 * fq;
        asm volatile("" : "+v"(row0), "+v"(col0));
        const int mr = row0 >> 12;
        float ss[2][4];
#pragma unroll
        for (int ai = 0; ai < 2; ++ai)
#pragma unroll
            for (int m = 0; m < 4; ++m) ss[ai][m] = 0.f;
#pragma unroll
        for (int bj = 0; bj < 2; ++bj) { const int c = col0 + bj * HALF;
            const f32x4 g0 = *(const f32x4*)(gate + (size_t)mr * 3072 + c), g1 = *(const f32x4*)(gate + (size_t)mr * 3072 + c + 4);
#pragma unroll
            for (int ai = 0; ai < 2; ++ai)
#pragma unroll
              for (int mh = 0; mh < 2; ++mh) {
                f32x4 xo[2][2];
#pragma unroll
                for (int mm = 0; mm < 2; ++mm) { const size_t ro = (size_t)(row0 + ai * HALF + (2 * mh + mm) * 16) * 1024 + c; xo[mm][0] = *(const f32x4*)(xin + ro); xo[mm][1] = *(const f32x4*)(xin + ro + 4); }
#pragma unroll
                for (int mm = 0; mm < 2; ++mm) asm volatile("" : "+v"(xo[mm][0]), "+v"(xo[mm][1]));
#pragma unroll
                for (int mm = 0; mm < 2; ++mm) { const int m = 2 * mh + mm;
                    const f32x4 x0 = xo[mm][0] + g0 * acc[ai][bj][m][0], x1 = xo[mm][1] + g1 * acc[ai][bj][m][1];
                    if (bj == 0) { acc[ai][0][m][0] = x0; acc[ai][0][m][1] = x1; }
                    else { *(LAS f32x4*)(park + ((ai * 4 + m) * 2 + 0) * 8192) = x0; *(LAS f32x4*)(park + ((ai * 4 + m) * 2 + 1) * 8192) = x1; }
                    ss[ai][m] += (x0[0] * x0[0] + x0[1] * x0[1]) + (x0[2] * x0[2] + x0[3] * x0[3]) + (x1[0] * x1[0] + x1[1] * x1[1]) + (x1[2] * x1[2] + x1[3] * x1[3]); }
                asm volatile("" ::: "memory"); } }
        const int ln = fr + 16 * fq; float got = 0.f;
#pragma unroll
        for (int ai = 0; ai < 2; ++ai)
#pragma unroll
            for (int m = 0; m < 4; ++m) { float v = ss[ai][m];
                v += __builtin_bit_cast(float, __builtin_amdgcn_ds_bpermute((ln ^ 16) << 2, __builtin_bit_cast(int, v))); v += __builtin_bit_cast(float, __builtin_amdgcn_ds_bpermute((ln ^ 32) << 2, __builtin_bit_cast(int, v)));
                if (fq == 0) got += atomicAdd(rss + row0 + ai * HALF + m * 16, v); }
        asm volatile("s_waitcnt vmcnt(0)" : "+v"(got) :: "memory");
        gu32* cnt = F.ctl() + CW_FIN + u.pm * FIN_STRIDE;
        if (ln == 0) __hip_atomic_fetch_add(cnt, 1u, RLX_AGENT);
        for (int it = 0; it < (1 << 20); ++it) { if (__hip_atomic_load(cnt, RLX_AGENT) >= 32u) break; __builtin_amdgcn_s_sleep(2); }
        asm volatile("" : "+v"(row0), "+v"(col0));
        float rs[2][4];
#pragma unroll
        for (int ai = 0; ai < 2; ++ai)
#pragma unroll
            for (int m = 0; m < 4; ++m) rs[ai][m] = __hip_atomic_load(rss + row0 + ai * HALF + m * 16, RLX_AGENT);
#pragma unroll
        for (int ai = 0; ai < 2; ++ai)
#pragma unroll
            for (int m = 0; m < 4; ++m) rs[ai][m] = __builtin_amdgcn_rsqf(rs[ai][m] * (1.f / 1024.f) + 1e-6f);
        float* out = F.out(); const float* fg = F.final_g();
#pragma unroll
        for (int bj = 0; bj < 2; ++bj) { const int c = col0 + bj * HALF;
            const f32x4 f0 = *(const f32x4*)(fg + c), f1 = *(const f32x4*)(fg + c + 4);
#pragma unroll
            for (int ai = 0; ai < 2; ++ai)
#pragma unroll
                for (int m = 0; m < 4; ++m) { const size_t ro = (size_t)(row0 + ai * HALF + m * 16) * 1024 + c;
                    f32x4 x0, x1;
                    if (bj == 0) { x0 = acc[ai][0][m][0]; x1 = acc[ai][0][m][1]; }
                    else { x0 = *(const LAS f32x4*)(park + ((ai * 4 + m) * 2 + 0) * 8192); x1 = *(const LAS f32x4*)(park + ((ai * 4 + m) * 2 + 1) * 8192); }
                    *(f32x4*)(out + ro) = x0 * rs[ai][m] * f0; *(f32x4*)(out + ro + 4) = x1 * rs[ai][m] * f1; } }
    }
};
struct EpiXg {
    static constexpr bool PERM = true, AFTER_DRAIN = false, PREFETCH = false;
    const Frame& F; int l; bool fused; int mall;
    __device__ __forceinline__ void operator()(const f32x4 (&acc)[2][2][4][2], const Unit& u, int wr, int wc, int fr, int fq) const {
        bf16_t* O = F.XG(); const float* rss = fused ? F.RSS(l) : nullptr; const float* sw = F.SW(l);
        const int row0 = u.pm * BM + wr * 64 + fr, col0 = u.pn * BM + wc * 32 + 8 * fq;
        float rs[2][4];
#pragma unroll
        for (int ai = 0; ai < 2; ++ai)
#pragma unroll
            for (int m = 0; m < 4; ++m) rs[ai][m] = rss ? rss[row0 + ai * HALF + m * 16] : 1024.f;
        f32x4 wsw[2][2];
#pragma unroll
        for (int bj = 0; bj < 2; ++bj) { wsw[bj][0] = (f32x4){0.f, 0.f, 0.f, 0.f}; wsw[bj][1] = wsw[bj][0];
            if (rss) { const float* sp = sw + (size_t)(row0 >> 12) * 3072 + col0 + bj * HALF; wsw[bj][0] = *(const f32x4*)sp; wsw[bj][1] = *(const f32x4*)(sp + 4); } }
#pragma unroll
        for (int ai = 0; ai < 2; ++ai)
#pragma unroll
            for (int m = 0; m < 4; ++m) rs[ai][m] = rss ? __builtin_amdgcn_rsqf(rs[ai][m] * (1.f / 1024.f) + 1e-6f) : 1.f;
#pragma unroll
        for (int bj = 0; bj < 2; ++bj) { const int c = col0 + bj * HALF, nb2 = c / 96, cin = c - nb2 * 96;
            bf16_t* cb = O + ((size_t)nb2 * mall) * 96 + cin;
            const f32x4 w0 = wsw[bj][0], w1 = wsw[bj][1];
#pragma unroll
            for (int ai = 0; ai < 2; ++ai)
#pragma unroll
                for (int m = 0; m < 4; ++m) { const int row = row0 + ai * HALF + m * 16; const f32x4 v0 = acc[ai][bj][m][0] * rs[ai][m] + w0, v1 = acc[ai][bj][m][1] * rs[ai][m] + w1;
                    u32x4 w; w.x = cvt_pk_bf16(v0[0], v0[1]); w.y = cvt_pk_bf16(v0[2], v0[3]); w.z = cvt_pk_bf16(v1[0], v1[1]); w.w = cvt_pk_bf16(v1[2], v1[3]);
                    *(u32x4*)(cb + (size_t)row * 96) = w; } }
    }
};
struct EpiQkv {
    static constexpr bool PERM = true, AFTER_DRAIN = false, PREFETCH = false;
    const Frame& F; int l; int j;
    __device__ __forceinline__ void operator()(const f32x4 (&acc)[2][2][4][2], const Unit& u, int wr, int wc, int fr, int fq) const {
        bf16_t* O = F.XG(); float* out = F.out(); const float* rss = F.RSS(l); const float* sw = F.SW(l);
        const int row0 = u.pm * BM + wr * 64 + fr; const int colt = u.pn * BM;
        const int gp = colt >> 10, g = gp / 3, part = gp - 3 * g;
        const int ld = (gp == 9) ? 4 : 2 * g;
        const bool kv = (gp < 9) && (part >= 1);
        const int W = 128 << (2 * g);
        const size_t offp = (g == 0) ? 17088512u : (g == 1) ? 19185664u : 27574272u;
        const int hd0 = (colt & 1023) + wc * 32 + 8 * fq;
        bf16_t* rbase = O + (size_t)gp * 16777216u + (size_t)(row0 >> 12) * 4194304u;
        float rs[2][4];
#pragma unroll
        for (int ai = 0; ai < 2; ++ai)
#pragma unroll
            for (int m = 0; m < 4; ++m) rs[ai][m] = rss[row0 + ai * HALF + m * 16];
        f32x4 wsw[2][2];
#pragma unroll
        for (int bj = 0; bj < 2; ++bj) { const float* sp = sw + (size_t)(row0 >> 12) * 10240 + colt + wc * 32 + 8 * fq + bj * HALF; wsw[bj][0] = *(const f32x4*)sp; wsw[bj][1] = *(const f32x4*)(sp + 4); }
#pragma unroll
        for (int ai = 0; ai < 2; ++ai)
#pragma unroll
            for (int m = 0; m < 4; ++m) rs[ai][m] = __builtin_amdgcn_rsqf(rs[ai][m] * (1.f / 1024.f) + 1e-6f);
#pragma unroll
        for (int bj = 0; bj < 2; ++bj) { const int hd = hd0 + bj * HALF;
            const f32x4 w0 = wsw[bj][0], w1 = wsw[bj][1];
#pragma unroll
            for (int ai = 0; ai < 2; ++ai)
#pragma unroll
                for (int m = 0; m < 4; ++m) { const int row = row0 + ai * HALF + m * 16; const int t = row & 4095;
                    const int pp = ((t & ((1 << ld) - 1)) << (12 - ld)) | (t >> ld);
                    const f32x4 v0 = acc[ai][bj][m][0] * rs[ai][m] + w0, v1 = acc[ai][bj][m][1] * rs[ai][m] + w1;
                    u32x4 w; w.x = cvt_pk_bf16(v0[0], v0[1]); w.y = cvt_pk_bf16(v0[2], v0[3]); w.z = cvt_pk_bf16(v1[0], v1[1]); w.w = cvt_pk_bf16(v1[2], v1[3]);
                    *(u32x4*)(rbase + ((size_t)((hd >> 6) * 4096 + pp)) * 64 + (hd & 63)) = w;
                    if (kv && t >= 4096 - W) { float* kvp = out + offp + ((size_t)((j * 4 + (row >> 12)) * W + (t - (4096 - W))) * 2 + (part - 1)) * 1024 + hd;
                        *(f32x4*)kvp = v0; *(f32x4*)(kvp + 4) = v1; } } }
    }
};
}
constexpr int SC_XP = 0, SC_GB_P = 53888, SC_GB_S = 73728, SC_W = 107136, SC_WP = 208, SC_AGG = 147072, SC_CIN = 153216, SC_COLC = 153600, SC_PAIR = 156672;
__device__ __forceinline__ size_t xb_off(int nb2, int row) { return ((size_t)nb2 * MALL + row) * 96; }

__device__ __forceinline__ float sp8_of(float lam) { const float x = __builtin_amdgcn_exp2f(-LOG2E * lam);
    const float ser = x * (1.f + x * (-0.5f + x * (0.33333334f + x * (-0.25f + x * (0.2f + x * (-0.16666667f))))));
    const float l1p = (x < 0.125f) ? ser : LN2 * __log2f(1.f + x);
    return -8.f * LOG2E * l1p; }
__device__ __forceinline__ void scan_stage_colc(Frame& F, int j, int nb, int tid) {
    const int col0 = nb * 96;
    float cc8 = 0.f, cc8b = 0.f;
    { const int e = tid, row = e / 96, c = e - row * 96, gcol = j * 1536 + col0 + c;
      if (e < 480) cc8 = (row < 4) ? F.lru_conv_w()[((size_t)j * 4 + row) * 1536 + col0 + c] : F.lru_conv_b()[gcol];
      if (e < 288) { const int r2 = e / 96, c2 = e - r2 * 96, g2 = j * 1536 + col0 + c2;
          cc8b = (r2 == 0) ? F.lru_ba()[g2] : (r2 == 1) ? F.lru_bx()[g2] : sp8_of(F.lru_lambda()[g2]); } }
    if (tid < 480) ((LAS float*)(F.lds + SC_COLC))[tid] = cc8;
    if (tid < 288) ((LAS float*)(F.lds + SC_COLC))[480 + tid] = cc8b;
}

__device__ __forceinline__ void carry_publish(unsigned long long* g, float v) { __hip_atomic_store(g, (1ull << 32) | (unsigned long long)__builtin_bit_cast(unsigned, v), __ATOMIC_RELAXED, __HIP_MEMORY_SCOPE_AGENT); }
__device__ __forceinline__ float carry_wait(unsigned long long* g) { unsigned long long x; unsigned spins = 0;
    for (;;) { x = __hip_atomic_load(g, __ATOMIC_RELAXED, __HIP_MEMORY_SCOPE_AGENT); if ((unsigned)(x >> 32) == 1u || ++spins > (1u << 22)) break; __builtin_amdgcn_s_sleep(1); }
    return __builtin_bit_cast(float, (unsigned)x); }
__device__ __forceinline__ void scan_xp_dma(Frame& F, int nb, int pm, int w, int lane) {
    const bf16* xt = F.XG() + xb_off(nb, pm * 256) - 288;
#pragma unroll
    for (int i = 0; i < 7; ++i) { const int p = w * 7 + i; if (p < 49) glds16(xt + (size_t)(p * 64 + lane) * 8, (unsigned)(size_t)(F.lds + SC_XP + p * 1024)); }
}
__device__ __forceinline__ void scan_core(Frame& F, int j, int pm, int nb, int tid_in, bool samp, int sb0, int next_pm) {
    LAS unsigned char* lds = F.lds;
    int tid_ = tid_in; asm volatile("" : "+v"(tid_));
    const int tid = tid_, lane = tid & 63, w = __builtin_amdgcn_readfirstlane(tid >> 6), fr = lane & 15, fq = lane >> 4;
    constexpr int SC_GB = SC_GB_P, GBP = 192, XPI = 192;
    const int col0 = nb * 96, b = pm >> 4, ci = pm & 15;
    const bool active = !samp || w < 4;
    {
        if (!samp) { if (ci == 15 && tid < 288) { const int q = tid / 96, c = tid - q * 96;
            F.out()[OFF_PCONV + ((size_t)(j * 4 + b) * 3 + q) * 1536 + col0 + c] = bf2f(*(const LAS bf16*)(lds + SC_XP + (256 + q) * XPI + c * 2)); } }
        else { for (int e = tid; e < 16 * 288; e += 512) { const int lb = e / 288, rem = e - lb * 288, q = rem / 96, c = rem - q * 96;
            F.out()[OFF_SCONV + ((size_t)(j * 32 + sb0 + lb) * 3 + q) * 1536 + col0 + c] = bf2f(*(const LAS bf16*)(lds + SC_XP + (lb * 11 + 8 + q) * XPI + c * 2)); } }
    }
    if (active) {
    const LAS float* colc = (const LAS float*)(lds + SC_COLC);
    bf16x8 Af[2][3];
#pragma unroll
    for (int ks = 0; ks < 3; ++ks) {
        const int c8 = 32 * ks + 8 * fq;
        f32x4 cw[4][2], cb[2];
#pragma unroll
        for (int t = 0; t < 4; ++t) { cw[t][0] = *(const LAS f32x4*)(colc + t * 96 + c8); cw[t][1] = *(const LAS f32x4*)(colc + t * 96 + c8 + 4); }
        cb[0] = *(const LAS f32x4*)(colc + 4 * 96 + c8); cb[1] = *(const LAS f32x4*)(colc + 4 * 96 + c8 + 4);
#pragma unroll
        for (int m = 0; m < 2; ++m) { const int row = 32 * w + 16 * m + fr; const int rb = samp ? (row >> 3) * 11 + (row & 7) : row;
            f32x4 a0 = cb[0], a1 = cb[1];
#pragma unroll
            for (int t = 0; t < 4; ++t) { const v4u xv = *(const LAS v4u*)(lds + SC_XP + (rb + t) * XPI + c8 * 2);
                a0.x += cw[t][0].x * bflo(xv.x); a0.y += cw[t][0].y * bfhi(xv.x); a0.z += cw[t][0].z * bflo(xv.y); a0.w += cw[t][0].w * bfhi(xv.y);
                a1.x += cw[t][1].x * bflo(xv.z); a1.y += cw[t][1].y * bfhi(xv.z); a1.z += cw[t][1].z * bflo(xv.w); a1.w += cw[t][1].w * bfhi(xv.w); }
            v4u pk; pk.x = pk2(a0.x, a0.y); pk.y = pk2(a0.z, a0.w); pk.z = pk2(a1.x, a1.y); pk.w = pk2(a1.z, a1.w);
            Af[m][ks] = __builtin_bit_cast(bf16x8, pk); }
    }
    bf16x8 sel0, sel1;
    { const int e0 = (fq == 0 && fr < 8) ? fr : (fq == 1 && fr >= 8) ? fr - 8 : -1, e1 = (fq == 2 && fr < 8) ? fr : (fq == 3 && fr >= 8) ? fr - 8 : -1;
#pragma unroll
      for (int e = 0; e < 8; ++e) { sel0[e] = (e == e0) ? (short)0x3F80 : (short)0; sel1[e] = (e == e1) ? (short)0x3F80 : (short)0; } }
    LAS f32x2* aggL = (LAS f32x2*)(lds + SC_AGG);
#pragma unroll
    for (int half = 0; half < 2; ++half) {
    f32x4 av[2][3], uv[2][3]; float Pq[2][3], Hq[2][3];
#pragma unroll
    for (int n3 = 0; n3 < 3; ++n3) {
        const int nt = 3 * half + n3;
        const int col = 16 * nt + fr;
        bf16x8 Ba[3], Bx[3];
#pragma unroll
        for (int ks = 0; ks < 3; ++ks) {
            Ba[ks] = *(const LAS bf16x8*)(lds + SC_W + col * SC_WP + 64 * ks + 16 * fq); Bx[ks] = *(const LAS bf16x8*)(lds + SC_W + (96 + col) * SC_WP + 64 * ks + 16 * fq); }
        const float ba = colc[480 + col], bx = colc[576 + col], sp8 = colc[672 + col];
        float P4[2], H4[2];
#pragma unroll
        for (int m = 0; m < 2; ++m) {
            f32x4 rp = (f32x4){0.f, 0.f, 0.f, 0.f}, ip = rp, xc = rp;
#pragma unroll
            for (int ks = 0; ks < 3; ++ks) { rp = __builtin_amdgcn_mfma_f32_16x16x32_bf16(Af[m][ks], Ba[ks], rp, 0, 0, 0); ip = __builtin_amdgcn_mfma_f32_16x16x32_bf16(Af[m][ks], Bx[ks], ip, 0, 0, 0); }
            xc = __builtin_amdgcn_mfma_f32_16x16x32_bf16(Af[m][nt >> 1], (nt & 1) ? sel1 : sel0, xc, 0, 0, 0);
            f32x4 a4, u4;
#pragma unroll
            for (int e = 0; e < 4; ++e) { const float rr = sigmoid_f(rp[e] + ba), ig = sigmoid_f(ip[e] + bx), la = sp8 * rr;
                const float a = __builtin_amdgcn_exp2f(la); a4[e] = a; u4[e] = __builtin_amdgcn_sqrtf(fmaxf(1.f - a * a, 0.f)) * ig * xc[e]; }
            av[m][n3] = a4; uv[m][n3] = u4;
            P4[m] = (a4[0] * a4[1]) * (a4[2] * a4[3]);
            H4[m] = ((u4[0] * a4[1] + u4[1]) * a4[2] + u4[2]) * a4[3] + u4[3];
        }
        if (!samp) {
            float Pt[2], Ht[2];
#pragma unroll
            for (int m = 0; m < 2; ++m) {
                float P = P4[m], H = H4[m];
                { const float Pn = shup(P, lane, 16), Hn = shup(H, lane, 16); if (fq >= 1) { H = P * Hn + H; P = P * Pn; } }
                { const float Pn = shup(P, lane, 32), Hn = shup(H, lane, 32); if (fq >= 2) { H = P * Hn + H; P = P * Pn; } }
                const float Pe = shup(P, lane, 16), He = shup(H, lane, 16);
                Pq[m][n3] = (fq == 0) ? 1.f : Pe; Hq[m][n3] = (fq == 0) ? 0.f : He;
                Pt[m] = shl(P, 48 + fr); Ht[m] = shl(H, 48 + fr);
            }
            Hq[1][n3] = Pq[1][n3] * Ht[0] + Hq[1][n3]; Pq[1][n3] = Pq[1][n3] * Pt[0];
            if (fq == 0) { f32x2 t; t.x = Pt[0] * Pt[1]; t.y = Pt[1] * Ht[0] + Ht[1]; aggL[w * 96 + col] = t; }
        } else {
#pragma unroll
            for (int m = 0; m < 2; ++m) { const float Pn = shup(P4[m], lane, 16), Hn = shup(H4[m], lane, 16);
                Pq[m][n3] = (fq & 1) ? Pn : 1.f; Hq[m][n3] = (fq & 1) ? Hn : 0.f; }
        }
    }
    if (!samp) {
        if (half == 0) asm volatile("s_waitcnt vmcnt(0)" ::: "memory");
        __syncthreads();
        if (half == 0 && next_pm >= 0) scan_xp_dma(F, nb, next_pm, w, lane);
        unsigned long long* ag = F.carry() + (((size_t)(j * 64 + pm)) * 1536 + col0 + 48 * half) * 2;
        float Pu = 1.f, Hu = 0.f;
        if (tid < 48) {
#pragma unroll
            for (int ww = 0; ww < 8; ++ww) { const f32x2 t = aggL[ww * 96 + 48 * half + tid]; Hu = t.x * Hu + t.y; Pu = t.x * Pu; }
            carry_publish(ag + 2 * tid, Pu); carry_publish(ag + 2 * tid + 1, Hu); }
        if (tid < 384) { const int c = tid % 48, grp = tid / 48, c0 = 2 * grp; float P = 1.f, H = 0.f;
            unsigned long long* pg = F.carry() + (((size_t)(j * 64 + pm - ci + c0)) * 1536 + col0 + 48 * half + c) * 2;
            if (c0 < ci) {
                const bool two = c0 + 1 < ci; unsigned long long x0, x1, x2, x3; unsigned spins = 0;
                for (;;) { x0 = __hip_atomic_load(pg, __ATOMIC_RELAXED, __HIP_MEMORY_SCOPE_AGENT); x1 = __hip_atomic_load(pg + 1, __ATOMIC_RELAXED, __HIP_MEMORY_SCOPE_AGENT);
                    x2 = two ? __hip_atomic_load(pg + 3072, __ATOMIC_RELAXED, __HIP_MEMORY_SCOPE_AGENT) : (1ull << 32); x3 = two ? __hip_atomic_load(pg + 3073, __ATOMIC_RELAXED, __HIP_MEMORY_SCOPE_AGENT) : (1ull << 32);
                    if ((((unsigned)(x0 >> 32) & (unsigned)(x1 >> 32) & (unsigned)(x2 >> 32) & (unsigned)(x3 >> 32)) == 1u) || ++spins > (1u << 22)) break; __builtin_amdgcn_s_sleep(1); }
                P = __builtin_bit_cast(float, (unsigned)x0); H = __builtin_bit_cast(float, (unsigned)x1);
                if (two) { const float p1 = __builtin_bit_cast(float, (unsigned)x2), h1 = __builtin_bit_cast(float, (unsigned)x3); H = p1 * H + h1; P = p1 * P; } }
            f32x2 t; t.x = P; t.y = H; ((LAS f32x2*)(lds + SC_PAIR))[grp * 48 + c] = t; }
        __syncthreads();
        if (tid < 48) { float c = 0.f;
#pragma unroll
            for (int grp = 0; grp < 8; ++grp) { const f32x2 t = ((const LAS f32x2*)(lds + SC_PAIR))[grp * 48 + tid]; c = t.x * c + t.y; }
            ((LAS float*)(lds + SC_CIN))[48 * half + tid] = c;
            if (ci == 15) F.out()[OFF_PH + ((size_t)j * 4 + b) * 1536 + col0 + 48 * half + tid] = Pu * c + Hu; }
        __syncthreads();
    }
    {
#pragma unroll
        for (int n3 = 0; n3 < 3; ++n3) {
            const int nt = 3 * half + n3;
            const int col = 16 * nt + fr;
            float cwv = 0.f;
            if (!samp) { cwv = ((const LAS float*)(lds + SC_CIN))[col];
#pragma unroll
                for (int ww = 0; ww < 7; ++ww) if (ww < w) { const f32x2 t = aggL[ww * 96 + col]; cwv = t.x * cwv + t.y; } }
#pragma unroll
            for (int m = 0; m < 2; ++m) {
                const int sb = sb0 + 4 * w + 2 * m + (fq >> 1);
                float c = cwv; if (samp) c = F.state_h()[((size_t)j * 32 + sb) * 1536 + col0 + col];
                float h = Pq[m][n3] * c + Hq[m][n3];
#pragma unroll
                for (int e = 0; e < 4; ++e) { h = av[m][n3][e] * h + uv[m][n3][e];
                    const int row = 32 * w + 16 * m + 4 * fq + e;
                    const float gbv = bf2f(*(const LAS bf16*)(lds + SC_GB + row * GBP + col * 2));
                    *(LAS bf16*)(lds + SC_GB + row * GBP + col * 2) = (bf16)f2bf(h * silu_f(gbv)); }
                if (samp && (fq & 1)) F.out()[OFF_SH + ((size_t)j * 32 + sb) * 1536 + col0 + col] = h;
            }
        }
    }
    }
    }
    {
        __syncthreads();
        const int nch = samp ? 1536 : 3072; const size_t yrow0 = samp ? (size_t)MP + 8 * sb0 : (size_t)pm * 256;
#pragma unroll
        for (int i = 0; i < 6; ++i) { const int ch = tid + 512 * i, r = ch / 12, cc = ch - r * 12;
            if (ch < nch) *(GAS v4u*)(F.Y() + (yrow0 + r) * 1536 + col0 + cc * 8) = *(const LAS v4u*)(lds + SC_GB + r * GBP + cc * 16); }
    }
}

__device__ __forceinline__ void scan_phase(Frame& F, int j) {
    LAS unsigned char* lds = F.lds;
    int tid_ = F.tid; asm volatile("" : "+v"(tid_));
    const int tid = tid_, lane = tid & 63, w = __builtin_amdgcn_readfirstlane(tid >> 6), fr = lane & 15, fq = lane >> 4;
    const bf16* XB = F.XG();
    int o = F.vcu, nb_staged = -1;
#define SCAN_PM(O) ((((O) >> 4) & 3) * 16 + ((O) >> 6))
    __syncthreads();
    if (o < 1024) scan_xp_dma(F, o & 15, SCAN_PM(o), w, lane);
    for (; o < 1056; o += F.G) {
        const bool samp = o >= 1024; const int nb = o & 15, pm = samp ? 64 : SCAN_PM(o), sb0 = samp ? ((o >> 4) & 1) * 16 : 0;
        if (nb != nb_staged) {
            __syncthreads();
            scan_stage_colc(F, j, nb, tid);
            v4u wr5[5];
#pragma unroll
            for (int i = 0; i < 5; ++i) { const int ch = tid + 512 * i; if (ch < 2304) { const int r = ch / 12, cc = ch - r * 12;
                const bf16* src = (r < 96 ? F.wa_t() : F.wx_t()) + ((size_t)(j * 16 + nb) * 96 + (r < 96 ? r : r - 96)) * 96 + cc * 8; wr5[i] = *(const GAS v4u*)src; } }
#pragma unroll
            for (int i = 0; i < 5; ++i) { const int ch = tid + 512 * i; if (ch < 2304) { const int r = ch / 12, cc = ch - r * 12; *(LAS v4u*)(lds + SC_W + r * SC_WP + cc * 16) = wr5[i]; } }
            nb_staged = nb;
        }
        if (!samp) {
            asm volatile("s_waitcnt vmcnt(0)" ::: "memory");
            if ((pm & 15) == 0 && tid < 36) *(LAS v4u*)(lds + SC_XP + tid * 16) = (v4u){0u, 0u, 0u, 0u};
        } else {
#pragma unroll 1
            for (int i = 0; i < 5; ++i) { const int ch = tid + 512 * i; if (ch < 16 * 11 * 12) { const int lr = ch / 12, cc = ch - lr * 12, lb = lr / 11, q = lr - lb * 11, sb = sb0 + lb;
                v4u val;
                if (q < 3) { const float* sp = F.state_conv() + ((size_t)((j * 32 + sb) * 3 + q)) * 1536 + nb * 96 + cc * 8; const f32x4 a = *(const f32x4*)sp, c = *(const f32x4*)(sp + 4);
                    val.x = pk2(a.x, a.y); val.y = pk2(a.z, a.w); val.z = pk2(c.x, c.y); val.w = pk2(c.z, c.w); }
                else val = *(const GAS v4u*)(XB + xb_off(nb, MP + sb * 8 + q - 3) + cc * 8);
                *(LAS v4u*)(lds + SC_XP + lr * 192 + cc * 16) = val; } }
        }
        __syncthreads();
        { const bf16* gt = XB + xb_off(16 + nb, samp ? MP + 8 * sb0 : pm * 256);
          const int npw = samp ? 3 : 6;
#pragma unroll
          for (int i = 0; i < 6; ++i) if (i < npw) glds16(gt + (size_t)((w * npw + i) * 64 + lane) * 8, (unsigned)(size_t)(lds + SC_GB_P + (w * npw + i) * 1024)); }
        if (samp) { asm volatile("s_waitcnt vmcnt(0)" ::: "memory"); __syncthreads(); }
        const int on = o + F.G;
        scan_core(F, j, pm, nb, tid, samp, sb0, (on < 1024 && (on & 15) == nb) ? SCAN_PM(on) : -1);
        if (on < 1024 && (on & 15) != nb) { __syncthreads(); scan_xp_dma(F, on & 15, SCAN_PM(on), w, lane); }
    }
#undef SCAN_PM
}

__device__ __forceinline__ s16x4 vtr(const LAS unsigned char* p) { typedef short v4i16_t __attribute__((ext_vector_type(4)));
    return __builtin_bit_cast(s16x4, __builtin_amdgcn_ds_read_tr16_b64_v4i16((LAS v4i16_t*)p)); }

constexpr int ATT_SLOT = 65536;
struct AttnPre { bf16x8 q0, q1; v2u po[4]; float plse; v2u gt[4]; };

__device__ __forceinline__ size_t qb_off(int gp, int b, int h, int pp) { return (size_t)gp * 16777216u + ((size_t)((b * 16 + h) * 4096 + pp)) * 64; }
__device__ __forceinline__ void attn_issue(Frame& F, int G, int u, int slot, AttnPre& P, int tid, int w, int fr, int fq) {
    const int ld = 2 * G, DIL = 1 << ld, NCH = 32 >> ld, L = 4096 >> ld;
    const int b = u >> 9, h = (u >> 5) & 15, q32 = u & 31, c = q32 & (NCH - 1), r = q32 >> (5 - ld);
    const int lane = tid & 63;
    const bf16* kt = F.XG() + qb_off(3 * G + 1, b, h, r * L + 128 * c - 128);
#pragma unroll
    for (int i = 0; i < 4; ++i) {
        const int row = w * 32 + i * 8 + (lane >> 3), s = lane & 7, ch = s ^ (row & 7);
        const bf16* kp = kt + row * 64 + ch * 8;
        const unsigned dst = (unsigned)(size_t)(F.lds + slot * ATT_SLOT + (w * 32 + i * 8) * 128);
        glds16(kp, dst); glds16(kp + 16777216, dst + 32768u);
    }
    const int pq = r * L + 128 * c + 16 * w + fr;
    const bf16* qp = F.XG() + qb_off(3 * G, b, h, pq) + 8 * fq;
    P.q0 = *(const bf16x8*)qp; P.q1 = *(const bf16x8*)(qp + 32);
    const int tq = (128 * c + 16 * w + fr) * DIL + r;
    if (G > 0) { const bf16* op = (const bf16*)F.OACC() + ((size_t)((b * 16 + h) * 4096 + tq)) * 64 + 4 * fq;
#pragma unroll
        for (int nt = 0; nt < 4; ++nt) P.po[nt] = *(const GAS v2u*)(op + 16 * nt);
        P.plse = F.lse()[(size_t)(b * 16 + h) * 4096 + tq]; }
    if (G == 2) { const bf16* gp = F.XG() + qb_off(9, b, h, pq) + 4 * fq;
#pragma unroll
        for (int nt = 0; nt < 4; ++nt) P.gt[nt] = *(const GAS v2u*)(gp + 16 * nt); }
}
__device__ __forceinline__ void attn_pin(AttnPre& P) {
    asm volatile("" : "+v"(P.q0), "+v"(P.q1));
#pragma unroll
    for (int nt = 0; nt < 4; ++nt) asm volatile("" : "+v"(P.po[nt]), "+v"(P.gt[nt]));
    asm volatile("" : "+v"(P.plse));
}

__device__ __forceinline__ void attn_compute(Frame& F, int G, int u, int slot, const AttnPre& P, int w, int fr_, int fq_) {
    const int ld = 2 * G, DIL = 1 << ld, NCH = 32 >> ld;
    int fr = fr_, fq = fq_; asm volatile("" : "+v"(fr), "+v"(fq));
    const int lane = fr + 16 * fq;
    const int b = u >> 9, h = (u >> 5) & 15, q32 = u & 31, c = q32 & (NCH - 1), r = q32 >> (5 - ld);
    const LAS unsigned char* kb = F.lds + slot * ATT_SLOT + (16 * w + fr) * 128;
    const LAS unsigned char* kb0 = kb + ((fq ^ (fr & 7)) << 4); const LAS unsigned char* kb1 = kb + (((4 + fq) ^ (fr & 7)) << 4);
    f32x4 st[9];
    { bf16x8 kf[9][2];
#pragma unroll
      for (int T = 0; T < 9; ++T) { kf[T][0] = *(const LAS bf16x8*)(kb0 + T * 2048); kf[T][1] = *(const LAS bf16x8*)(kb1 + T * 2048); }
#pragma unroll
      for (int T = 0; T < 9; ++T) { f32x4 s = (f32x4){0.f, 0.f, 0.f, 0.f};
        s = __builtin_amdgcn_mfma_f32_16x16x32_bf16(kf[T][0], P.q0, s, 0, 0, 0); s = __builtin_amdgcn_mfma_f32_16x16x32_bf16(kf[T][1], P.q1, s, 0, 0, 0); st[T] = s; } }
    const float slope = __builtin_amdgcn_exp2f(-0.5f * (float)(h + 1));
    const float c1 = 0.125f * LOG2E, c2 = slope * (float)DIL * LOG2E;
    const float d0 = (float)(fr - 4 * fq + 128) * c2;
    float mx = -1e30f;
#pragma unroll
    for (int T = 0; T < 9; ++T)
#pragma unroll
        for (int e = 0; e < 4; ++e) { float s2 = st[T][e] * c1 - (d0 - c2 * (float)(16 * T + e));
            if (T == 0) s2 = (4 * fq + e >= fr) ? s2 : -1e30f;
            if (T == 8) s2 = (4 * fq + e <= fr) ? s2 : -1e30f;
            st[T][e] = s2; }
    if (c == 0) {
        const int thr = 128 - 16 * w - 4 * fq;
#pragma unroll
        for (int T = 0; T < 9; ++T)
#pragma unroll
            for (int e = 0; e < 4; ++e) st[T][e] = (16 * T + e >= thr) ? st[T][e] : -1e30f;
    }
#pragma unroll
    for (int T = 0; T < 9; ++T) mx = fmaxf(mx, fmaxf(fmaxf(st[T][0], st[T][1]), fmaxf(st[T][2], st[T][3])));
    mx = fmaxf(mx, shx(mx, lane, 16)); mx = fmaxf(mx, shx(mx, lane, 32));
    float ls = 0.f;
#pragma unroll
    for (int T = 0; T < 9; ++T)
#pragma unroll
        for (int e = 0; e < 4; ++e) { const float p = __builtin_amdgcn_exp2f(st[T][e] - mx); ls += p; st[T][e] = p; }
    ls += shx(ls, lane, 16); ls += shx(ls, lane, 32);
    f32x4 o[4];
#pragma unroll
    for (int nt = 0; nt < 4; ++nt) o[nt] = (f32x4){0.f, 0.f, 0.f, 0.f};
    const int sw = 4 * (fq & 1) + (fr >> 2);
    const LAS unsigned char* vrow = F.lds + slot * ATT_SLOT + 32768 + (16 * w + 4 * fq + (fr >> 2)) * 128 + (fr & 1) * 8;
    const LAS unsigned char* vbs[4];
#pragma unroll
    for (int nt = 0; nt < 4; ++nt) vbs[nt] = vrow + (((2 * nt + ((fr >> 1) & 1)) ^ sw) << 4);
    s16x4 vl[5][4], vh[4][4];
#pragma unroll
    for (int kk = 0; kk < 5; ++kk)
#pragma unroll
        for (int nt = 0; nt < 4; ++nt) { vl[kk][nt] = vtr(vbs[nt] + kk * 4096); if (kk < 4) vh[kk][nt] = vtr(vbs[nt] + kk * 4096 + 2048); }
#pragma unroll
    for (int kk = 0; kk < 5; ++kk) {
        v4u pk; pk.x = pk2(st[2 * kk][0], st[2 * kk][1]); pk.y = pk2(st[2 * kk][2], st[2 * kk][3]);
        if (kk < 4) { const int t1 = (2 * kk + 1 < 9) ? 2 * kk + 1 : 8; pk.z = pk2(st[t1][0], st[t1][1]); pk.w = pk2(st[t1][2], st[t1][3]); } else { pk.z = 0u; pk.w = 0u; }
        const bf16x8 pf = __builtin_bit_cast(bf16x8, pk);
#pragma unroll
        for (int nt = 0; nt < 4; ++nt) {
            const s16x4 lo = vl[kk][nt], hi = (kk < 4) ? vh[kk < 4 ? kk : 3][nt] : lo;
            bf16x8 vf; vf[0] = lo[0]; vf[1] = lo[1]; vf[2] = lo[2]; vf[3] = lo[3]; vf[4] = hi[0]; vf[5] = hi[1]; vf[6] = hi[2]; vf[7] = hi[3];
            o[nt] = __builtin_amdgcn_mfma_f32_16x16x32_bf16(vf, pf, o[nt], 0, 0, 0); }
    }
    const float inv = __builtin_amdgcn_rcpf(ls);
#pragma unroll
    for (int nt = 0; nt < 4; ++nt) o[nt] = o[nt] * inv;
    float lse = (mx + __log2f(ls)) * LN2;
    const int tq = (128 * c + 16 * w + fr) * DIL + r; const size_t row = (size_t)b * SEQ + tq;
    if (G > 0) { const float lp = P.plse; const float m2 = fmaxf(lp, lse); const float ln = m2 + __logf(__expf(lp - m2) + __expf(lse - m2));
        const float wp = __expf(lp - ln), wc = __expf(lse - ln);
#pragma unroll
        for (int nt = 0; nt < 4; ++nt) { const v2u pv = P.po[nt]; const f32x4 po = (f32x4){bflo(pv.x), bfhi(pv.x), bflo(pv.y), bfhi(pv.y)}; o[nt] = po * wp + o[nt] * wc; }
        lse = ln; }
    if (G == 2) {
#pragma unroll
        for (int nt = 0; nt < 4; ++nt) { const v2u gw = P.gt[nt];
            v2u y; y.x = pk2(o[nt].x * silu_f(bflo(gw.x)), o[nt].y * silu_f(bfhi(gw.x))); y.y = pk2(o[nt].z * silu_f(bflo(gw.y)), o[nt].w * silu_f(bfhi(gw.y)));
            *(GAS v2u*)(F.Y() + row * 1024 + h * 64 + 16 * nt + 4 * fq) = y; }
    } else { bf16* op = (bf16*)F.OACC() + ((size_t)((b * 16 + h) * 4096 + tq)) * 64 + 4 * fq;
#pragma unroll
        for (int nt = 0; nt < 4; ++nt) { v2u pv; pv.x = pk2(o[nt].x, o[nt].y); pv.y = pk2(o[nt].z, o[nt].w); *(GAS v2u*)(op + 16 * nt) = pv; }
        if (fq == 0) F.lse()[(size_t)(b * 16 + h) * 4096 + tq] = lse; }
}

struct BlkList { int sub, ns, sp0, sps, glo, ghi; };
__device__ __forceinline__ int blk_count(const BlkList& L) { return L.sub == 0 ? (L.ghi - L.glo) * L.ns * 4 : L.ns * 8; }
__device__ __forceinline__ void blk_at(const BlkList& L, int i, int& G, int& u) {
    if (L.sub != 0) { const int sp = L.sp0 + (i >> 3) * L.sps; G = 2; u = sp * 8 + (i & 7); return; }
    const int per = L.ns * 4, gi = i / per, r = i - gi * per, sp = L.sp0 + (r >> 2) * L.sps, k = r & 3, bh = sp >> 3, c5 = sp & 7;
    G = L.glo + gi; u = (G == 0) ? bh * 32 + 4 * c5 + k : bh * 32 + c5 + 8 * k;
}
__device__ __forceinline__ void attn_blocks(Frame& F, const BlkList& L) {
    int tid_ = F.tid; asm volatile("" : "+v"(tid_));
    const int tid = tid_, lane = tid & 63, w = __builtin_amdgcn_readfirstlane(tid >> 6), fr = lane & 15, fq = lane >> 4;
    const int n = blk_count(L);
    if (n <= 0) return;
    asm volatile("s_waitcnt vmcnt(0)" ::: "memory");
    __syncthreads();
    AttnPre Pc, Pn;
#pragma unroll
    for (int nt = 0; nt < 4; ++nt) { Pc.po[nt] = (v2u){0u, 0u}; Pc.gt[nt] = (v2u){0u, 0u}; } Pc.plse = 0.f; Pn = Pc;
    int Gc, uc; blk_at(L, 0, Gc, uc);
    attn_issue(F, Gc, uc, 0, Pc, tid, w, fr, fq);
    asm volatile("s_waitcnt vmcnt(0)" ::: "memory"); attn_pin(Pc);
    asm volatile("s_waitcnt lgkmcnt(0)\n\ts_barrier" ::: "memory");
    for (int i = 0; i < n; ++i) {
        const int slot = i & 1;
        int Gn, un; blk_at(L, (i + 1 < n) ? i + 1 : i, Gn, un);
        attn_issue(F, Gn, un, slot ^ 1, Pn, tid, w, fr, fq);
        attn_compute(F, Gc, uc, slot, Pc, w, fr, fq);
        asm volatile("s_waitcnt vmcnt(4)" ::: "memory"); attn_pin(Pn);
        asm volatile("s_waitcnt lgkmcnt(0)\n\ts_barrier" ::: "memory");
        Pc = Pn; Gc = Gn; uc = un;
    }
}

__device__ __forceinline__ void up16(const v4u& a, const v4u& c, float (&x)[16]) {
    x[0] = bflo(a.x); x[1] = bfhi(a.x); x[2] = bflo(a.y); x[3] = bfhi(a.y); x[4] = bflo(a.z); x[5] = bfhi(a.z); x[6] = bflo(a.w); x[7] = bfhi(a.w);
    x[8] = bflo(c.x); x[9] = bfhi(c.x); x[10] = bflo(c.y); x[11] = bfhi(c.y); x[12] = bflo(c.z); x[13] = bfhi(c.z); x[14] = bflo(c.w); x[15] = bfhi(c.w); }
__device__ __forceinline__ void attn_sample_task(Frame& F, int G, int j, int sb, int t, int pair, int hf) {
    const int ld = 2 * G, DIL = 1 << ld, BUF = 128 << ld;
    LAS unsigned char* lds = F.lds;
    int tid_ = F.tid; asm volatile("" : "+v"(tid_));
    const int lane = tid_ & 63, w = __builtin_amdgcn_readfirstlane(tid_ >> 6), h = lane >> 2;
    const float* cache = F.A->in[4 + G];
    const float* cbase = cache + (size_t)(j * 32 + sb) * BUF * 2048 + 16 * lane;
    const bf16* qs = F.QS() + G * 3072 + 16 * lane;
    const int t2 = t + DIL;
    float qa[16], qb[16];
    { const bf16* p = qs + ((size_t)sb * 8 + t) * NQKVG; const v4u a = *(const GAS v4u*)p, c = *(const GAS v4u*)(p + 8); up16(a, c, qa); }
    { const bf16* p = qs + ((size_t)sb * 8 + (pair ? t2 : t)) * NQKVG; const v4u a = *(const GAS v4u*)p, c = *(const GAS v4u*)(p + 8); up16(a, c, qb); }
    const float slope = __builtin_amdgcn_exp2f(-0.5f * (float)(h + 1));
    const float c1 = 0.125f * LOG2E, c2 = slope * (float)DIL * LOG2E;
    float ma = -1e30f, la = 0.f, oa[16], mb = -1e30f, lb = 0.f, ob[16];
#pragma unroll
    for (int e = 0; e < 16; ++e) { oa[e] = 0.f; ob[e] = 0.f; }
    const int nnew = t >> ld;
    { const int s = w - 1;
      if (hf == 0 && s <= nnew && (s >= 0 || pair)) { const bf16* kp = qs + ((size_t)sb * 8 + (t - DIL * s)) * NQKVG + 1024;
        const v4u a = *(const GAS v4u*)kp, c = *(const GAS v4u*)(kp + 8), d = *(const GAS v4u*)(kp + 1024), f = *(const GAS v4u*)(kp + 1032);
        float kx[16], vx[16]; up16(a, c, kx); up16(d, f, vx);
        float da = 0.f, db = 0.f;
#pragma unroll
        for (int e = 0; e < 16; ++e) { da += qa[e] * kx[e]; db += qb[e] * kx[e]; }
        da += shx(da, lane, 1); da += shx(da, lane, 2); db += shx(db, lane, 1); db += shx(db, lane, 2);
        if (s >= 0) { ma = da * c1 - c2 * (float)s; la = 1.f;
#pragma unroll
            for (int e = 0; e < 16; ++e) oa[e] = vx[e]; }
        if (pair) { mb = db * c1 - c2 * (float)(s + 1); lb = 1.f;
#pragma unroll
            for (int e = 0; e < 16; ++e) ob[e] = vx[e]; } } }
    const int slo = hf ? 65 : nnew + 1, shi = hf ? 128 : 64;
    for (int s0 = slo + w; s0 <= shi; s0 += 32) {
        f32x4 kk[4][4], vv[4][4];
#pragma unroll
        for (int i = 0; i < 4; ++i) { const int s = s0 + 8 * i, sc = s <= shi ? s : shi; const float* kp = cbase + (size_t)(BUF + t - DIL * sc) * 2048;
#pragma unroll
            for (int e4 = 0; e4 < 4; ++e4) { kk[i][e4] = *(const f32x4*)(kp + 4 * e4); vv[i][e4] = *(const f32x4*)(kp + 1024 + 4 * e4); } }
        float sa[4], sbv[4];
#pragma unroll
        for (int i = 0; i < 4; ++i) { float da = 0.f, db = 0.f;
#pragma unroll
            for (int e4 = 0; e4 < 4; ++e4) { da += qa[4 * e4] * kk[i][e4].x + qa[4 * e4 + 1] * kk[i][e4].y + qa[4 * e4 + 2] * kk[i][e4].z + qa[4 * e4 + 3] * kk[i][e4].w;
                                             db += qb[4 * e4] * kk[i][e4].x + qb[4 * e4 + 1] * kk[i][e4].y + qb[4 * e4 + 2] * kk[i][e4].z + qb[4 * e4 + 3] * kk[i][e4].w; }
            da += shx(da, lane, 1); da += shx(da, lane, 2); db += shx(db, lane, 1); db += shx(db, lane, 2);
            const int s = s0 + 8 * i; sa[i] = (s <= shi) ? da * c1 - c2 * (float)s : -1e30f; sbv[i] = (pair && s <= shi && s < 128) ? db * c1 - c2 * (float)(s + 1) : -1e30f; }
        { const float mn = fmaxf(fmaxf(ma, sa[0]), fmaxf(fmaxf(sa[1], sa[2]), sa[3])), al = __builtin_amdgcn_exp2f(ma - mn);
          float p[4];
#pragma unroll
          for (int i = 0; i < 4; ++i) p[i] = __builtin_amdgcn_exp2f(sa[i] - mn);
          la = la * al + (p[0] + p[1]) + (p[2] + p[3]); ma = mn;
#pragma unroll
          for (int e4 = 0; e4 < 4; ++e4) {
            oa[4 * e4] = oa[4 * e4] * al + (p[0] * vv[0][e4].x + p[1] * vv[1][e4].x) + (p[2] * vv[2][e4].x + p[3] * vv[3][e4].x);
            oa[4 * e4 + 1] = oa[4 * e4 + 1] * al + (p[0] * vv[0][e4].y + p[1] * vv[1][e4].y) + (p[2] * vv[2][e4].y + p[3] * vv[3][e4].y);
            oa[4 * e4 + 2] = oa[4 * e4 + 2] * al + (p[0] * vv[0][e4].z + p[1] * vv[1][e4].z) + (p[2] * vv[2][e4].z + p[3] * vv[3][e4].z);
            oa[4 * e4 + 3] = oa[4 * e4 + 3] * al + (p[0] * vv[0][e4].w + p[1] * vv[1][e4].w) + (p[2] * vv[2][e4].w + p[3] * vv[3][e4].w); } }
        if (pair) { const float mn = fmaxf(fmaxf(mb, sbv[0]), fmaxf(fmaxf(sbv[1], sbv[2]), sbv[3])), al = __builtin_amdgcn_exp2f(mb - mn);
          float p[4];
#pragma unroll
          for (int i = 0; i < 4; ++i) p[i] = __builtin_amdgcn_exp2f(sbv[i] - mn);
          lb = lb * al + (p[0] + p[1]) + (p[2] + p[3]); mb = mn;
#pragma unroll
          for (int e4 = 0; e4 < 4; ++e4) {
            ob[4 * e4] = ob[4 * e4] * al + (p[0] * vv[0][e4].x + p[1] * vv[1][e4].x) + (p[2] * vv[2][e4].x + p[3] * vv[3][e4].x);
            ob[4 * e4 + 1] = ob[4 * e4 + 1] * al + (p[0] * vv[0][e4].y + p[1] * vv[1][e4].y) + (p[2] * vv[2][e4].y + p[3] * vv[3][e4].y);
            ob[4 * e4 + 2] = ob[4 * e4 + 2] * al + (p[0] * vv[0][e4].z + p[1] * vv[1][e4].z) + (p[2] * vv[2][e4].z + p[3] * vv[3][e4].z);
            ob[4 * e4 + 3] = ob[4 * e4 + 3] * al + (p[0] * vv[0][e4].w + p[1] * vv[1][e4].w) + (p[2] * vv[2][e4].w + p[3] * vv[3][e4].w); } }
    }
    __syncthreads();
    LAS float* oL = (LAS float*)lds; LAS f32x2* mlL = (LAS f32x2*)(lds + 65536);
#pragma unroll
    for (int e4 = 0; e4 < 4; ++e4) { *(LAS f32x4*)(oL + w * 1024 + 16 * lane + 4 * e4) = (f32x4){oa[4 * e4], oa[4 * e4 + 1], oa[4 * e4 + 2], oa[4 * e4 + 3]};
                                     *(LAS f32x4*)(oL + 8192 + w * 1024 + 16 * lane + 4 * e4) = (f32x4){ob[4 * e4], ob[4 * e4 + 1], ob[4 * e4 + 2], ob[4 * e4 + 3]}; }
    { f32x2 x; x.x = ma; x.y = la; mlL[w * 64 + lane] = x; x.x = mb; x.y = lb; mlL[512 + w * 64 + lane] = x; }
    __syncthreads();
    if (w == 0 || (w == 1 && pair)) {
        const LAS float* oq = oL + w * 8192; const LAS f32x2* mq = mlL + w * 512; const int task = sb * 8 + (w ? t2 : t);
        float M = -1e30f;
#pragma unroll
        for (int ww = 0; ww < 8; ++ww) M = fmaxf(M, mq[ww * 64 + lane].x);
        float Lsum = 0.f; f32x4 acc[4];
#pragma unroll
        for (int e4 = 0; e4 < 4; ++e4) acc[e4] = (f32x4){0.f, 0.f, 0.f, 0.f};
#pragma unroll
        for (int ww = 0; ww < 8; ++ww) { const f32x2 x = mq[ww * 64 + lane]; const float sc = __builtin_amdgcn_exp2f(x.x - M); Lsum += x.y * sc;
#pragma unroll
            for (int e4 = 0; e4 < 4; ++e4) acc[e4] = acc[e4] + *(const LAS f32x4*)(oq + ww * 1024 + 16 * lane + 4 * e4) * sc; }
        const float inv = (Lsum > 0.f) ? 1.f / Lsum : 0.f; const float lse = (Lsum > 0.f) ? (M + __log2f(Lsum)) * LN2 : -1e30f;
        float* op = F.SO() + ((size_t)(G * 2 + hf) * 256 + task) * 1024 + 16 * lane;
#pragma unroll
        for (int e4 = 0; e4 < 4; ++e4) *(f32x4*)(op + 4 * e4) = acc[e4] * inv;
        if ((lane & 3) == 0) F.SLSE()[((size_t)(G * 2 + hf) * 256 + task) * 16 + h] = lse;
    }
}
__device__ __forceinline__ void attn_sample_combine(Frame& F, int task) {
    int tid_ = F.tid; asm volatile("" : "+v"(tid_));
    const int c = 2 * tid_, h = c >> 6; const size_t qrow = (size_t)MP + task;
    float l[6]; f32x2 a[6]; float mx = -1e30f;
#pragma unroll
    for (int p = 0; p < 6; ++p) { l[p] = F.SLSE()[((size_t)p * 256 + task) * 16 + h]; a[p] = *(const f32x2*)(F.SO() + ((size_t)p * 256 + task) * 1024 + c); }
    const unsigned gw = *(const GAS unsigned*)(F.QS() + (size_t)task * NQKVG + 9216 + c);
#pragma unroll
    for (int p = 0; p < 6; ++p) mx = fmaxf(mx, l[p]);
    float den = 0.f, o0 = 0.f, o1 = 0.f;
#pragma unroll
    for (int p = 0; p < 6; ++p) { const float e = __expf(l[p] - mx); den += e; o0 += a[p].x * e; o1 += a[p].y * e; }
    const float inv = 1.f / den;
    *(GAS unsigned*)(F.Y() + qrow * 1024 + c) = pk2(o0 * inv * silu_f(bflo(gw)), o1 * inv * silu_f(bfhi(gw)));
}

__device__ __forceinline__ void attn_phase(Frame& F, int sub, int j) {
    const int nunit = sub == 0 ? 512 : 256, ngg = sub == 0 ? 2 : 1;
    const bool tasks_first = false;
    for (int pass = 0; pass < 2; ++pass) {
        if ((pass == 0) == tasks_first) {
            if (sub == 0) {
                for (int x = F.vcu; x < 1024; x += F.G) { const int id = x & 511; int g, sb, t, pair, hf;
                    if (x < 512) { const int r = id >> 1, pr = (r >> 1) & 3; g = id & 1; hf = r & 1; sb = r >> 3; t = g ? pr : 2 * pr; pair = 1; }
                    else { const int task = id >> 1; g = 2; hf = id & 1; sb = task >> 3; t = task & 7; pair = 0; }
                    attn_sample_task(F, g, j, sb, t, pair, hf); } }
        } else {
            const int ns = (nunit - F.vcu + F.G - 1) / F.G;
            const int ncall = (sub == 0 && ns < 2) ? 2 : 1;
            for (int cl = 0; cl < ncall; ++cl) { BlkList L; L.sub = sub; L.ns = ns; L.sp0 = F.vcu; L.sps = F.G; L.glo = (ncall == 2) ? cl : 0; L.ghi = (ncall == 2) ? cl + 1 : 2; attn_blocks(F, L); }
        }
    }
    if (sub == 1) for (int task = F.vcu; task < 256; task += F.G) attn_sample_combine(F, task);
}
template <int NT, class Epi>
__device__ __forceinline__ void sgemm_unit(Frame& F, const bf16* A, const bf16* Bt, int K, int n0, const Epi& E) {
    int tid_ = F.tid; asm volatile("" : "+v"(tid_));
    const int lane = tid_ & 63, w = __builtin_amdgcn_readfirstlane(tid_ >> 6), fr = lane & 15, fq = lane >> 4;
    constexpr int STAGE = (256 + 16 * NT) * 128;
    static_assert(3 * STAGE <= RING_BYTES + 16384, "sgemm ring");
    f32x4 acc[2][NT];
#pragma unroll
    for (int m = 0; m < 2; ++m)
#pragma unroll
        for (int nt = 0; nt < NT; ++nt) acc[m][nt] = (f32x4){0.f, 0.f, 0.f, 0.f};
    const int nch = K >> 6;
    const int r8 = lane >> 3, s8 = lane & 7;
    const bf16* asrc[4];
#pragma unroll
    for (int i = 0; i < 4; ++i) { const int row = w * 32 + i * 8 + r8; asrc[i] = A + (size_t)row * K + ((s8 ^ (row & 7)) << 3); }
    const int bp = w % (2 * NT), brow = bp * 8 + r8;
    const bf16* bsrc = Bt + (size_t)(n0 + brow) * K + ((s8 ^ (brow & 7)) << 3);
#define SG_ISSUE(C, SLOT) do { const unsigned sb_ = (unsigned)(size_t)(F.lds + (SLOT) * STAGE); \
        _Pragma("unroll") for (int i = 0; i < 4; ++i) glds16(asrc[i] + (size_t)(C) * 64, sb_ + (unsigned)((w * 32 + i * 8) * 128)); \
        glds16(bsrc + (size_t)(C) * 64, sb_ + 32768u + (unsigned)(bp * 1024)); } while (0)
    __syncthreads();
    SG_ISSUE(0, 0); SG_ISSUE(1, 1);
    int slot = 0;
    for (int c = 0; c < nch; ++c) {
        if (c + 1 < nch) asm volatile("s_waitcnt vmcnt(5)" ::: "memory"); else asm volatile("s_waitcnt vmcnt(0)" ::: "memory");
        asm volatile("s_waitcnt lgkmcnt(0)\n\ts_barrier" ::: "memory");
        if (c + 2 < nch) { const int s2 = (slot + 2 >= 3) ? slot - 1 : slot + 2; SG_ISSUE(c + 2, s2); }
        const LAS unsigned char* sa = F.lds + slot * STAGE; const LAS unsigned char* sbp = sa + 32768;
        bf16x8 af[2][2], bq[NT][2];
#pragma unroll
        for (int m = 0; m < 2; ++m)
#pragma unroll
            for (int ks = 0; ks < 2; ++ks) { const int row = 32 * w + 16 * m + fr; af[m][ks] = *(const LAS bf16x8*)(sa + row * 128 + (((4 * ks + fq) ^ (row & 7)) << 4)); }
#pragma unroll
        for (int nt = 0; nt < NT; ++nt)
#pragma unroll
            for (int ks = 0; ks < 2; ++ks) { const int row = 16 * nt + fr; bq[nt][ks] = *(const LAS bf16x8*)(sbp + row * 128 + (((4 * ks + fq) ^ (row & 7)) << 4)); }
#pragma unroll
        for (int ks = 0; ks < 2; ++ks)
#pragma unroll
            for (int m = 0; m < 2; ++m)
#pragma unroll
                for (int nt = 0; nt < NT; ++nt) acc[m][nt] = __builtin_amdgcn_mfma_f32_16x16x32_bf16(bq[nt][ks], af[m][ks], acc[m][nt], 0, 0, 0);
        slot = (slot == 2) ? 0 : slot + 1;
    }
#undef SG_ISSUE
    typename Epi::Pre pre[2][NT];
#pragma unroll
    for (int m = 0; m < 2; ++m)
#pragma unroll
        for (int nt = 0; nt < NT; ++nt) pre[m][nt] = E.ld(32 * w + 16 * m + fr, n0 + 16 * nt + 4 * fq);
#pragma unroll
    for (int m = 0; m < 2; ++m)
#pragma unroll
        for (int nt = 0; nt < NT; ++nt) E.st(acc[m][nt], pre[m][nt], 32 * w + 16 * m + fr, n0 + 16 * nt + 4 * fq);
    if constexpr (Epi::HAS_FINISH) E.template finish<NT>(acc, w, fr, fq, n0);
}
struct SEpiXg { static constexpr bool HAS_FINISH = false; const Frame& F; int l; bool fused;
    struct Pre { f32x4 sw; float rss; };
    __device__ __forceinline__ Pre ld(int row, int col) const { Pre p; p.sw = (f32x4){0.f, 0.f, 0.f, 0.f}; p.rss = 1024.f;
        if (fused) { p.rss = F.RSS(l)[MP + row]; p.sw = *(const f32x4*)(F.SW(l) + (size_t)(4 + (row >> 3)) * 3072 + col); } return p; }
    __device__ __forceinline__ void st(const f32x4& a, const Pre& p, int row, int col) const { const int nb2 = col / 96, cin = col - nb2 * 96;
        f32x4 v = a; if (fused) v = a * __builtin_amdgcn_rsqf(p.rss * (1.f / 1024.f) + 1e-6f) + p.sw;
        v2u wv; wv.x = pk2(v.x, v.y); wv.y = pk2(v.z, v.w); *(GAS v2u*)(F.XG() + ((size_t)nb2 * MALL + MP + row) * 96 + cin) = wv; } };
struct SEpiResid { static constexpr bool HAS_FINISH = true; const Frame& F; int l; bool hasnext; bool fin;
    struct Pre { f32x4 x, g, gn, sc; };
    __device__ __forceinline__ Pre ld(int row, int col) const { Pre p; const int mr = 4 + (row >> 3);
        const float* xin = (l == 0) ? F.x_sample() : F.XL(l - 1) + (size_t)MP * 1024;
        p.x = *(const f32x4*)(xin + (size_t)row * 1024 + col); p.g = *(const f32x4*)(F.mod() + (size_t)l * 36 * 3072 + 2048 + (size_t)mr * 3072 + col);
        p.gn = p.g; p.sc = p.g;
        if (hasnext) { p.gn = *(const f32x4*)(F.norm_g() + (l + 1) * 1024 + col); p.sc = *(const f32x4*)(F.mod() + (size_t)(l + 1) * 36 * 3072 + 1024 + (size_t)mr * 3072 + col); } return p; }
    __device__ __forceinline__ void st(f32x4& v, const Pre& p, int row, int col) const {
        const f32x4 x = p.x + p.g * v;
        if (fin) { v = x; return; }
        *(f32x4*)(F.XL(l) + (size_t)(MP + row) * 1024 + col) = x;
        if (hasnext) { const f32x4 h = x * p.gn * (p.sc + 1.f);
            v2u wv; wv.x = pk2(h.x, h.y); wv.y = pk2(h.z, h.w); *(GAS v2u*)(F.HN() + (size_t)(MP + row) * 1024 + col) = wv;
            float s = (x.x * x.x + x.y * x.y) + (x.z * x.z + x.w * x.w); const int fq = (col >> 2) & 3, ln = (row & 15) + 16 * fq;
            s += __builtin_bit_cast(float, __builtin_amdgcn_ds_bpermute((ln ^ 16) << 2, __builtin_bit_cast(int, s))); s += __builtin_bit_cast(float, __builtin_amdgcn_ds_bpermute((ln ^ 32) << 2, __builtin_bit_cast(int, s)));
            if (fq == 0) atomicAdd(F.RSS(l + 1) + MP + row, s); } }
    template <int NT> __device__ __forceinline__ void finish(f32x4 (&acc)[2][NT], int w, int fr, int fq, int n0) const {
        if (!fin) return;
        float* rss = F.RSS(0) + MP; const int ln = fr + 16 * fq; float got = 0.f;
#pragma unroll
        for (int m = 0; m < 2; ++m) { float s = 0.f;
#pragma unroll
            for (int nt = 0; nt < NT; ++nt) { const f32x4 x = acc[m][nt]; s += (x.x * x.x + x.y * x.y) + (x.z * x.z + x.w * x.w); }
            s += __builtin_bit_cast(float, __builtin_amdgcn_ds_bpermute((ln ^ 16) << 2, __builtin_bit_cast(int, s))); s += __builtin_bit_cast(float, __builtin_amdgcn_ds_bpermute((ln ^ 32) << 2, __builtin_bit_cast(int, s)));
            if (fq == 0) got += atomicAdd(rss + 32 * w + 16 * m + fr, s); }
        asm volatile("s_waitcnt vmcnt(0)" : "+v"(got) :: "memory");
        gu32* cnt = F.ctl() + CW_FIN + 64 * FIN_STRIDE;
        if (ln == 0) __hip_atomic_fetch_add(cnt, 1u, RLX_AGENT);
        for (int it = 0; it < (1 << 20); ++it) { if (__hip_atomic_load(cnt, RLX_AGENT) >= 128u) break; __builtin_amdgcn_s_sleep(2); }
        float* out = F.out() + OFF_YS; const float* fg = F.final_g();
#pragma unroll
        for (int m = 0; m < 2; ++m) { const int row = 32 * w + 16 * m + fr; const float rs = __builtin_amdgcn_rsqf(__hip_atomic_load(rss + row, RLX_AGENT) * (1.f / 1024.f) + 1e-6f);
#pragma unroll
            for (int nt = 0; nt < NT; ++nt) { const int col = n0 + 16 * nt + 4 * fq; *(f32x4*)(out + (size_t)row * 1024 + col) = acc[m][nt] * rs * *(const f32x4*)(fg + col); } }
    } };
struct SEpiQkv { static constexpr bool HAS_FINISH = false; const Frame& F; int l; int j;
    struct Pre { f32x4 sw; float rss; };
    __device__ __forceinline__ Pre ld(int row, int col) const { Pre p; p.rss = F.RSS(l)[MP + row]; p.sw = *(const f32x4*)(F.SW(l) + (size_t)(4 + (row >> 3)) * 10240 + col); return p; }
    __device__ __forceinline__ void st(const f32x4& a, const Pre& p, int row, int col) const {
        const f32x4 v = a * __builtin_amdgcn_rsqf(p.rss * (1.f / 1024.f) + 1e-6f) + p.sw;
        v2u wv; wv.x = pk2(v.x, v.y); wv.y = pk2(v.z, v.w); *(GAS v2u*)(F.QS() + (size_t)row * NQKVG + col) = wv;
        const int g = col / 3072, part = (col % 3072) / 1024;
        if (g < 3 && part >= 1) { const size_t offs = (g == 0) ? OFF_SKV0 : (g == 1) ? OFF_SKV1 : OFF_SKV2;
            *(f32x4*)(F.out() + offs + ((size_t)(j * 256 + row) * 2 + (part - 1)) * 1024 + (col % 1024)) = v; } } };
struct SEpiSW { static constexpr bool HAS_FINISH = false; float* O; int ldc;
    struct Pre { int dummy; };
    __device__ __forceinline__ Pre ld(int, int) const { Pre p; p.dummy = 0; return p; }
    __device__ __forceinline__ void st(const f32x4& v, const Pre&, int row, int col) const { if (row < 36) *(f32x4*)(O + (size_t)row * ldc + col) = v; } };
__device__ __forceinline__ void flush_caches(Frame& F) {
    const float* src = F.cache2() + (size_t)F.vcu * 524288;
    f32x4 acc = (f32x4){0.f, 0.f, 0.f, 0.f};
    for (int i = F.tid; i < 131072; i += 512) acc = acc + *(const f32x4*)(src + (size_t)i * 4);
    if (acc.x + acc.y + acc.z + acc.w == 12345.678f) F.lse()[0] = acc.x;
}
#ifndef MK_PER_PHASE
#define MK_PER_PHASE 0
#endif
constexpr int NPHASES = 18;
__global__ void __launch_bounds__(NWAVES * 64, 2) fwd_kernel(Args args) {
    extern __shared__ __attribute__((aligned(16))) unsigned char lds[];
    Frame F;
    F.lds = (LAS unsigned char*)lds;
    F.MISC = (volatile LAS unsigned*)(F.lds + MISC_OFF);
    F.tid = threadIdx.x;
    F.G = gridDim.x; { const int bx = blockIdx.x; F.vcu = (F.G % 8 == 0) ? (bx % 8) * (F.G / 8) + bx / 8 : bx; }
    F.A = (const __attribute__((address_space(4))) Args*)__builtin_amdgcn_kernarg_segment_ptr(); F.ws = args.ws; F.sA = 0; F.sO = 0;
    for (int u = F.tid; u < (LDS_BYTES - LDSCTL_OFF) / 4; u += NWAVES * 64) ((LAS unsigned*)(F.lds + LDSCTL_OFF))[u] = 0u;
    __syncthreads();
    const int lo = args.ph_lo, hi = args.ph_hi;
    XcdBarrier bar; bar.bar = (unsigned*)(F.ctl() + CW_BAR); bar.x = 0; bar.st = nullptr;
    if (hi - lo > 1) bar = xcd_barrier_post((unsigned*)(F.ctl() + CW_BAR), F.MISC + 8);
#ifndef PHMASK
#define PHMASK 0xFFF
#endif
#define IN(k) (lo <= (k) && (k) < hi)
#define WAVE_ID() __builtin_amdgcn_readfirstlane(F.tid >> 6)
#define LAUNDER() do { F.A = (const __attribute__((address_space(4))) Args*)(unsigned long long)launder_ptr((const void*)(unsigned long long)F.A); F.ws = (unsigned char*)launder_ptr(F.ws); } while (0)
#ifndef SKIPMASK
#define SKIPMASK 0
#endif
#define EN(b) (((PHMASK >> (b)) & 1) && !(((SKIPMASK >> (b)) & 1) && pass == NPASS - 1 && NPASS > 1 && skipjj))
#ifndef REPMASK
#define REPMASK 0
#endif
#define REP(b) (((REPMASK >> (b)) & 1) ? 2 : 1)
#ifndef FLUSHMASK
#define FLUSHMASK 0
#endif
#define FLUSH(b) do { if ((FLUSHMASK >> (b)) & 1) { XcdBarrier b3 = bar; b3.bar = (unsigned*)launder_ptr(b3.bar); xcd_barrier(b3); flush_caches(F); xcd_barrier(b3); } } while (0)
#define SEAM(k) do { if (IN(k) && IN((k) + 1)) { XcdBarrier b2 = bar; b2.bar = (unsigned*)launder_ptr(b2.bar); xcd_barrier(b2); if (REPMASK & 0x10000) xcd_barrier(b2); } } while (0)

#ifndef NPASS
#define NPASS 1
#endif
    const bool fusef = (F.G >= 256) && IN(16) && IN(17);
    for (int pass = 0; pass < NPASS; ++pass) {
    bool skipjj = true;
    if (pass > 0) { XcdBarrier b2 = bar; b2.bar = (unsigned*)launder_ptr(b2.bar); xcd_barrier(b2);
        for (int i = F.vcu * 512 + F.tid; i < 4 * MALL; i += F.G * 512) F.RSS(0)[i] = 0.f; xcd_barrier(b2); }
    LAUNDER(); if (EN(0) && IN(0)) { _Pragma("nounroll") for (int rep = 0; rep < REP(0); ++rep) { p0_prologue(F); __syncthreads(); } } SEAM(0);
    for (int jj = 0; jj < 2; ++jj) {
        const int pb = 1 + 8 * jj; skipjj = (jj == 1); F.sA = 2 * jj; F.sO = jj;
        const int l0 = 2 * jj, l1 = 2 * jj + 1;
        if (jj == 0) { LAUNDER(); if (EN(1) && IN(pb + 0)) { norm_phase(F, 0); } SEAM(pb + 0); }
        LAUNDER(); if (EN(2) && IN(pb + 1)) {
            pg8::Gemm g{F.H(), F.lwin_t() + (size_t)jj * 3072 * 1024, MP, 3072, 1024}; pg8::StaticOrder S; S.init(MP, 3072, F.G, (int)blockIdx.x);
            pg8::EpiXg E{F, l0, jj != 0, MALL};
            pg8::gemm_phase<pg8::EpiXg, pg8::StaticOrder, true, true>(F.lds + RING_OFF, g, S, E);
            const SEpiXg SE{F, l0, jj != 0};
            for (int u = F.vcu; u < 48; u += F.G) sgemm_unit<4>(F, F.H() + (size_t)MP * 1024, F.lwin_t() + (size_t)jj * 3072 * 1024, 1024, 64 * u, SE);
            if (F.vcu >= 48) conv_items(F, jj, CV_LIN, CV_AIN, F.vcu - 48, F.G - 48);
        } SEAM(pb + 1);
        LAUNDER(); if (EN(4) && IN(pb + 2)) { scan_phase(F, jj); __syncthreads(); } SEAM(pb + 2);
        LAUNDER(); if (EN(5) && IN(pb + 3)) {
            pg8::Gemm g{F.Y(), F.lwout_t() + (size_t)jj * 1024 * 1536, MP, 1024, 1536}; pg8::StaticOrder S; S.init(MP, 1024, F.G, (int)blockIdx.x);
            pg8::EpiResid E{F, l0, true};
            pg8::gemm_phase<pg8::EpiResid, pg8::StaticOrder, true, true>(F.lds + RING_OFF, g, S, E);
            const SEpiResid SE{F, l0, true, false};
            for (int u = F.vcu; u < 16; u += F.G) sgemm_unit<4>(F, F.Y() + (size_t)MP * 1536, F.lwout_t() + (size_t)jj * 1024 * 1536, 1536, 64 * u, SE);
            const SEpiSW SW1{F.SW(l1), 10240};
            for (int u = F.vcu - 16; u >= 0 && u < 160; u += F.G) sgemm_unit<4>(F, F.SHB(l1), F.awin_t() + (size_t)jj * 10240 * 1024, 1024, 64 * u, SW1);
        } SEAM(pb + 3);
        F.sA = 2 * jj + 1;
        LAUNDER(); if (EN(6) && IN(pb + 4)) {
            pg8::Gemm g{F.H(), F.awin_t() + (size_t)jj * 10240 * 1024, MP, 10240, 1024}; pg8::StaticOrder S; S.init(MP, 10240, F.G, (int)blockIdx.x);
            pg8::EpiQkv E{F, l1, jj};
            pg8::gemm_phase<pg8::EpiQkv, pg8::StaticOrder, true, true>(F.lds + RING_OFF, g, S, E);
            const SEpiQkv SE{F, l1, jj};
            for (int u = F.vcu; u < 160; u += F.G) sgemm_unit<4>(F, F.H() + (size_t)MP * 1024, F.awin_t() + (size_t)jj * 10240 * 1024, 1024, 64 * u, SE);
            if (F.vcu >= 160) { conv_items(F, jj, CV_AIN, CV_AOUT, F.vcu - 160, F.G - 160);
                if (jj == 0) conv_items(F, 1, 0, CV_LIN, F.vcu - 160, F.G - 160); }
        } SEAM(pb + 4);
        _Pragma("nounroll") for (int sub = 0; sub < 2; ++sub) {
            LAUNDER(); if (EN(7) && IN(pb + 5 + sub)) { attn_phase(F, sub, jj); if (sub == 1) __syncthreads(); } SEAM(pb + 5 + sub);
        }
        LAUNDER(); if (EN(10) && IN(pb + 7)) {
            pg8::Gemm g{F.Y(), F.awout_t() + (size_t)jj * 1024 * 1024, MP, 1024, 1024}; pg8::StaticOrder S; S.init(MP, 1024, F.G, (int)blockIdx.x);
            if (jj == 1 && fusef) { pg8::EpiFinal E{F, l1}; pg8::gemm_phase<pg8::EpiFinal, pg8::StaticOrder, true, true>(F.lds + RING_OFF, g, S, E); }
            else { pg8::EpiResid E{F, l1, jj == 0}; pg8::gemm_phase<pg8::EpiResid, pg8::StaticOrder, true, true>(F.lds + RING_OFF, g, S, E); }
            const SEpiResid SE{F, l1, jj == 0, jj == 1 && fusef};
            for (int u = F.vcu; u < 16; u += F.G) sgemm_unit<4>(F, F.Y() + (size_t)MP * 1024, F.awout_t() + (size_t)jj * 1024 * 1024, 1024, 64 * u, SE);
            const SEpiSW SW2{F.SW(2), 3072};
            if (jj == 0) for (int u = F.vcu - 16; u >= 0 && u < 48; u += F.G) sgemm_unit<4>(F, F.SHB(2), F.lwin_t() + (size_t)3072 * 1024, 1024, 64 * u, SW2);
        } if (!(jj == 1 && fusef)) SEAM(pb + 7);
    }
    skipjj = true;
    LAUNDER(); if (EN(11) && IN(17) && !fusef) { _Pragma("nounroll") for (int rep = 0; rep < REP(11); ++rep) final_phase(F); }
    FLUSH(12);
    }
#undef IN
#undef WAVE_ID
#undef LAUNDER
#undef EN
#undef REP
#undef FLUSH
#undef SEAM
}

extern "C" void kernel_launch(void* const* d_in, const int* in_sizes, int n_in, void* d_out, int out_size, void* d_ws, size_t ws_size, hipStream_t stream) {
    static int grid = 0;
    if (grid == 0) {
        if (n_in != 24 || out_size != (int)OUT_TOTAL || ws_size < WS_END) { fprintf(stderr, "kernel_launch: unexpected shapes: n_in %d out %d ws %zu; nothing launched\n", n_in, out_size, ws_size); grid = -1; return; }
        int dev = 0, cus = 0, per_cu = 0;
        if (hipGetDevice(&dev) != hipSuccess || hipDeviceGetAttribute(&cus, hipDeviceAttributeMultiprocessorCount, dev) != hipSuccess) { fprintf(stderr, "kernel_launch: device query failed\n"); grid = -1; return; }
        if (hipFuncSetAttribute((const void*)fwd_kernel, hipFuncAttributeMaxDynamicSharedMemorySize, LDS_BYTES) != hipSuccess) { fprintf(stderr, "kernel_launch: hipFuncSetAttribute failed\n"); grid = -1; return; }
        if (hipOccupancyMaxActiveBlocksPerMultiprocessor(&per_cu, (const void*)fwd_kernel, NWAVES * 64, LDS_BYTES) != hipSuccess || per_cu < 1)
            fprintf(stderr, "kernel_launch: note: occupancy query reports %d workgroups per CU\n", per_cu);
        (void)hipGetLastError();
        grid = cus;
    }
    if (grid < 0) return;
    if (hipMemsetAsync((char*)d_ws + WS_CARRY, 0, CARRY_BYTES, stream) != hipSuccess || hipMemsetAsync((char*)d_ws + WS_CTL, 0, CTL_ZERO_BYTES, stream) != hipSuccess) { fprintf(stderr, "kernel_launch: memset failed\n"); return; }
    Args a{};
    for (int i = 0; i < 24; ++i) a.in[i] = (const float*)d_in[i];
    a.outp = (float*)d_out; a.ws = (unsigned char*)d_ws;
#if MK_PER_PHASE
    for (int p = 0; p < NPHASES; ++p) { a.ph_lo = p; a.ph_hi = p + 1; hipLaunchKernelGGL(fwd_kernel, dim3(grid), dim3(NWAVES * 64), LDS_BYTES, stream, a); }
#else
    a.ph_lo = 0; a.ph_hi = NPHASES;
    hipLaunchKernelGGL(fwd_kernel, dim3(grid), dim3(NWAVES * 64), LDS_BYTES, stream, a);
#endif
    const hipError_t le = hipPeekAtLastError();
    if (le != hipSuccess) fprintf(stderr, "kernel_launch: launch failed: %s\n", hipGetErrorName(le));
}
```

```cpp
#include <hip/hip_runtime.h>
#include <cstdio>
#include <cstdint>
#define MK_PER_PHASE 0
namespace pg8 {
#define PG8_LAS __attribute__((address_space(3)))
typedef unsigned short bf16_t;
typedef short bf16x8 __attribute__((ext_vector_type(8)));
typedef float f32x4 __attribute__((ext_vector_type(4)));
typedef unsigned u32x4 __attribute__((ext_vector_type(4)));
constexpr int BM = 256, BK = 64, HALF = 128, HTB = HALF * BK * 2  , STAGE_BYTES = 8 * HTB, NXCD = 8, WGM = 4;

__host__ __device__ __forceinline__ int lds_byte(int r, int c) { const int st = (r >> 4) * 2 + (c >> 5), rr = r & 15, cc = c & 31, ob = rr * 64 + cc * 2; return st * 1024 + (ob ^ (((ob >> 9) & 1) << 5)); }
__host__ __device__ __forceinline__ void stage_rc(int b, int& R, int& C) { const int st = b / 1024, sb = b % 1024, swz = sb ^ (((sb >> 9) & 1) << 5); R = (st >> 1) * 16 + swz / 64; C = (st & 1) * 32 + (swz % 64) / 2; }
__host__ __device__ __forceinline__ int perm32(int rho) { const int n = rho >> 4, i = rho & 15; return 8 * (i >> 2) + 4 * n + (i & 3); }

struct Unit { int pm, pn; };
struct Gemm { const bf16_t* A; const bf16_t* Bt; int M, N, K; };

struct StaticOrder {
    int nM, nN, nwg, G, c, rot;
    __host__ __device__ void init(int M, int N, int G_, int c_, int rot_ = 0) { nM = M / BM; nN = N / BM; nwg = nM * nN; G = G_; c = c_; rot = rot_; }
    __host__ __device__ bool next(int i, Unit& u) const {
        const long L = (long)i * G + c; if (L >= nwg) return false;
        int wgid = (int)L; { const int q = nwg / NXCD, r = nwg % NXCD, xcd = wgid % NXCD, off = wgid / NXCD; wgid = (xcd < r ? xcd * (q + 1) : r * (q + 1) + (xcd - r) * q) + off; }
        const int nig = WGM * nN, gid = wgid / nig, fm = gid * WGM, gsz = (nM - fm) < WGM ? (nM - fm) : WGM;
        u.pm = fm + ((wgid % nig) % gsz); u.pn = (wgid % nig) / gsz + rot; if (u.pn >= nN) u.pn -= nN; return true;
    }
    __device__ __forceinline__ void a_ready(const Unit&) const {}
    __device__ __forceinline__ void done(const Unit&) const {}
};

__device__ __forceinline__ unsigned cvt_pk_bf16(float lo, float hi) { unsigned r; asm volatile("v_cvt_pk_bf16_f32 %0, %1, %2" : "=v"(r) : "v"(lo), "v"(hi)); return r; }
typedef float f32x2 __attribute__((ext_vector_type(2)));
__device__ __forceinline__ f32x2 gelu_pk(f32x2 v) {
    const f32x2 av = __builtin_elementwise_abs(v), d = av * 0.2316418882f + 1.0f;
    f32x2 t; t.x = __builtin_amdgcn_rcpf(d.x); t.y = __builtin_amdgcn_rcpf(d.y);
    f32x2 q = t * 0.5307027145f + (-0.7265760135f); q = q * t + 0.7107068705f; q = q * t + (-0.142248368f); q = q * t + 0.127414796f; q = q * t;
    const f32x2 s = (v * v) * (-0.72134752044f);
    f32x2 e; e.x = __builtin_amdgcn_exp2f(s.x); e.y = __builtin_amdgcn_exp2f(s.y);
    const f32x2 m = v * (q * e), r = v - m;
    f32x2 o; o.x = v.x < 0.f ? m.x : r.x; o.y = v.y < 0.f ? m.y : r.y; return o;
}

template <int ACT  > struct EpiBf16 {
    static constexpr bool PERM = true, AFTER_DRAIN = false, PREFETCH = false; static_assert(ACT == 0 || ACT == 1, "EpiBf16: ACT is 0 (none) or 1 (gelu_pk)");
    bf16_t* O; int ldc; const float* bias; int split_cols; size_t split_stride; float scale0;
    __device__ __forceinline__ void operator()(const f32x4 (&acc)[2][2][4][2], const Unit& u, int wr, int wc, int fr, int fq) const {
        const int row0 = u.pm * BM + wr * 64 + fr; int colt = u.pn * BM; bf16_t* base = O;
        float sc = 1.f; if (split_cols) { const int t = colt / split_cols; base += (size_t)t * split_stride; colt -= t * split_cols; if (t == 0) sc = scale0; }
        const int col0 = colt + wc * 32 + 8 * fq, bcol0 = u.pn * BM + wc * 32 + 8 * fq;
        f32x4 bv[2][2];
#pragma unroll
        for (int bj = 0; bj < 2; ++bj)
#pragma unroll
            for (int n = 0; n < 2; ++n) bv[bj][n] = bias ? *(const f32x4*)(bias + bcol0 + bj * HALF + 4 * n) : (f32x4){0.f, 0.f, 0.f, 0.f};
#pragma unroll
        for (int ai = 0; ai < 2; ++ai)
#pragma unroll
            for (int m = 0; m < 4; ++m) { bf16_t* rowp = base + (size_t)(row0 + ai * HALF + m * 16) * ldc + col0;
#pragma unroll
                for (int bj = 0; bj < 2; ++bj) { f32x4 v0 = acc[ai][bj][m][0] + bv[bj][0], v1 = acc[ai][bj][m][1] + bv[bj][1];
                    if (ACT == 1) { f32x2 a = gelu_pk((f32x2){v0[0], v0[1]}), b = gelu_pk((f32x2){v0[2], v0[3]}), c = gelu_pk((f32x2){v1[0], v1[1]}), d = gelu_pk((f32x2){v1[2], v1[3]});
                        v0 = (f32x4){a.x, a.y, b.x, b.y}; v1 = (f32x4){c.x, c.y, d.x, d.y}; }
                    v0 = v0 * sc; v1 = v1 * sc; u32x4 w; w.x = cvt_pk_bf16(v0[0], v0[1]); w.y = cvt_pk_bf16(v0[2], v0[3]); w.z = cvt_pk_bf16(v1[0], v1[1]); w.w = cvt_pk_bf16(v1[2], v1[3]);
                    *(u32x4*)(rowp + bj * HALF) = w; } }
    }
};
template <class Epi, class Sched, bool ALIGN_EPI = false, bool SP2 = false>
__device__ __forceinline__ void gemm_phase(PG8_LAS unsigned char* lds, const Gemm g, const Sched& S, const Epi& E) {
    int tid_ = threadIdx.x; asm volatile("" : "+v"(tid_));
    const int tid = tid_, wid = __builtin_amdgcn_readfirstlane(tid >> 6), lane = tid & 63, wr = wid >> 2, wc = wid & 3, fr = lane & 15, fq = lane >> 4;
    const int K = g.K, nt = K / BK;
    unsigned voffA[2], voffB[2];
#pragma unroll
    for (int i = 0; i < 2; ++i) { int R, C; stage_rc(tid * 16 + i * 8192, R, C); const int Rb = Epi::PERM ? ((R & ~31) + perm32(R & 31)) : R;
        voffA[i] = (unsigned)(R * K + C) * 2u; voffB[i] = (unsigned)(Rb * K + C) * 2u; }
    const size_t kstep = (size_t)(BK * 2);
    const size_t hstep = (size_t)HALF * K * 2;
    const size_t tstep = 2 * hstep;
    const unsigned ldsw = (unsigned)wid * 1024u;
    const int aoff = lds_byte(wr * 64 + fr, fq * 8), boff = lds_byte(wc * 32 + fr, fq * 8);
#define PG8_SA(b, h) (((b) * 2 + (h)) * HTB)
#define PG8_SB(b, h) ((4 + (b) * 2 + (h)) * HTB)
#define PG8_STAGE(bufoff, gbase, voff) do { _Pragma("unroll") for (int _i = 0; _i < 2; ++_i) \
        __builtin_amdgcn_global_load_lds((const unsigned*)((const char*)(gbase) + (voff)[_i]), (PG8_LAS unsigned*)(lds + (bufoff) + ldsw + _i * 8192), 16, 0, 0); } while (0)
#define PG8_LDA(dst, b, h) do { _Pragma("unroll") for (int m = 0; m < 4; ++m) _Pragma("unroll") for (int k = 0; k < 2; ++k) dst[m][k] = *(const PG8_LAS bf16x8*)(lds + PG8_SA(b, h) + aoff + m * 2048 + k * 1024); } while (0)
#define PG8_LDB(dst, b, h) do { _Pragma("unroll") for (int n = 0; n < 2; ++n) _Pragma("unroll") for (int k = 0; k < 2; ++k) dst[n][k] = *(const PG8_LAS bf16x8*)(lds + PG8_SB(b, h) + boff + n * 2048 + k * 1024); } while (0)
#define PG8_MMA(ai, bj, At, Bt) do { __builtin_amdgcn_s_setprio(1); _Pragma("unroll") for (int m = 0; m < 4; ++m) _Pragma("unroll") for (int n = 0; n < 2; ++n) _Pragma("unroll") for (int k = 0; k < 2; ++k) \
        acc[ai][bj][m][n] = __builtin_amdgcn_mfma_f32_16x16x32_bf16(Bt[n][k], At[m][k], acc[ai][bj][m][n], 0, 0, 0); __builtin_amdgcn_s_setprio(0); } while (0)
#define PG8_WAIT_V(n) asm volatile("s_waitcnt vmcnt(" #n ")" ::: "memory")
#define PG8_WAIT_L(n) asm volatile("s_waitcnt lgkmcnt(" #n ")" ::: "memory")
#define PG8_BAR __builtin_amdgcn_s_barrier()
#define PG8_SCHED __builtin_amdgcn_sched_barrier(0)
    Unit cur, nxt; int ui = 0;
    if (!S.next(0, cur)) return;
    f32x4 acc[2][2][4][2];
#pragma unroll
    for (int a = 0; a < 2; ++a)
#pragma unroll
        for (int b = 0; b < 2; ++b)
#pragma unroll
            for (int m = 0; m < 4; ++m)
#pragma unroll
                for (int n = 0; n < 2; ++n) acc[a][b][m][n] = (f32x4){0.f, 0.f, 0.f, 0.f};
    bf16x8 At[4][2], B0[2][2], B1[2][2];
    const char* cA = (const char*)g.A + (size_t)cur.pm * tstep; const char* cB = (const char*)g.Bt + (size_t)cur.pn * tstep;
    S.a_ready(cur);
    if constexpr (SP2) {
        PG8_STAGE(PG8_SB(0, 0), cB, voffB); PG8_STAGE(PG8_SB(0, 1), cB + hstep, voffB); PG8_STAGE(PG8_SA(0, 0), cA, voffA); PG8_STAGE(PG8_SA(0, 1), cA + hstep, voffA);
        if (wr == 1) PG8_BAR;
        PG8_WAIT_V(2); PG8_BAR;
        PG8_STAGE(PG8_SB(1, 0), cB + kstep, voffB); PG8_STAGE(PG8_SA(1, 0), cA + kstep, voffA); PG8_STAGE(PG8_SB(1, 1), cB + hstep + kstep, voffB);
        PG8_WAIT_V(6); PG8_BAR;
    } else {
        PG8_STAGE(PG8_SB(0, 0), cB, voffB); PG8_STAGE(PG8_SA(0, 0), cA, voffA); PG8_STAGE(PG8_SB(0, 1), cB + hstep, voffB); PG8_STAGE(PG8_SA(0, 1), cA + hstep, voffA);
        if (wr == 1) PG8_BAR;
        PG8_WAIT_V(4); PG8_BAR;
        PG8_STAGE(PG8_SB(1, 0), cB + kstep, voffB); PG8_STAGE(PG8_SA(1, 0), cA + kstep, voffA); PG8_STAGE(PG8_SB(1, 1), cB + hstep + kstep, voffB);
        PG8_WAIT_V(6); PG8_BAR;
    }
    for (;;) {
        const bool has_next = S.next(ui + 1, nxt);
        const char* nA = has_next ? (const char*)g.A + (size_t)nxt.pm * tstep : cA; const char* nB = has_next ? (const char*)g.Bt + (size_t)nxt.pn * tstep : cB;
        for (int t = 0; t < nt; t += 2) {
            const bool last = (t == nt - 2);
            const char* a1 = cA + (size_t)(t + 1) * kstep;
            const char* a2 = last ? nA : cA + (size_t)(t + 2) * kstep; const char* b2 = last ? nB : cB + (size_t)(t + 2) * kstep;
            const char* a3 = a2 + kstep; const char* b3 = b2 + kstep;
            if constexpr (Epi::PREFETCH) { if (t < 16) E.prefetch(cur, t >> 1, wid, wr, wc, lane); }
            if (last && has_next) S.a_ready(nxt);
            if constexpr (SP2) {
            PG8_LDB(B0, 0, 0); PG8_LDB(B1, 0, 1); PG8_SCHED; PG8_LDA(At, 0, 0); PG8_STAGE(PG8_SA(1, 1), a1 + hstep, voffA);
            PG8_WAIT_V(8); PG8_WAIT_L(0); PG8_BAR; PG8_MMA(0, 0, At, B0); PG8_MMA(0, 1, At, B1); PG8_BAR; PG8_SCHED;
            PG8_LDA(At, 0, 1); PG8_STAGE(PG8_SB(0, 0), b2, voffB); PG8_STAGE(PG8_SB(0, 1), b2 + hstep, voffB); PG8_STAGE(PG8_SA(0, 0), a2, voffA);
            PG8_WAIT_V(8); PG8_WAIT_L(0); PG8_BAR; PG8_MMA(1, 0, At, B0); PG8_MMA(1, 1, At, B1); PG8_BAR; PG8_SCHED;
            PG8_LDB(B0, 1, 0); PG8_LDB(B1, 1, 1); PG8_SCHED; PG8_LDA(At, 1, 0); PG8_STAGE(PG8_SA(0, 1), a2 + hstep, voffA);
            PG8_WAIT_V(8); PG8_WAIT_L(0); PG8_BAR; PG8_MMA(0, 0, At, B0); PG8_MMA(0, 1, At, B1); PG8_BAR; PG8_SCHED;
            PG8_LDA(At, 1, 1); PG8_STAGE(PG8_SB(1, 0), b3, voffB); PG8_STAGE(PG8_SB(1, 1), b3 + hstep, voffB); PG8_STAGE(PG8_SA(1, 0), a3, voffA);
            PG8_WAIT_V(8); PG8_WAIT_L(0); PG8_BAR; PG8_MMA(1, 0, At, B0); PG8_MMA(1, 1, At, B1); PG8_BAR; PG8_SCHED;
            } else {
            PG8_LDB(B0, 0, 0); PG8_SCHED; PG8_LDA(At, 0, 0); PG8_STAGE(PG8_SA(1, 1), a1 + hstep, voffA);
            PG8_WAIT_L(8); PG8_BAR; PG8_WAIT_L(0); PG8_MMA(0, 0, At, B0); PG8_BAR; PG8_SCHED;
            PG8_LDB(B1, 0, 1); PG8_STAGE(PG8_SB(0, 0), b2, voffB);
            PG8_BAR; PG8_WAIT_L(0); PG8_MMA(0, 1, At, B1); PG8_BAR;
            PG8_LDA(At, 0, 1); PG8_STAGE(PG8_SA(0, 0), a2, voffA);
            PG8_BAR; PG8_WAIT_L(0); PG8_MMA(1, 0, At, B0); PG8_BAR; PG8_SCHED;
            PG8_STAGE(PG8_SB(0, 1), b2 + hstep, voffB);
            PG8_WAIT_V(6); PG8_BAR; PG8_MMA(1, 1, At, B1); PG8_BAR;
            PG8_LDB(B0, 1, 0); PG8_SCHED; PG8_LDA(At, 1, 0); PG8_STAGE(PG8_SA(0, 1), a2 + hstep, voffA);
            PG8_WAIT_L(8); PG8_BAR; PG8_WAIT_L(0); PG8_MMA(0, 0, At, B0); PG8_BAR; PG8_SCHED;
            PG8_LDB(B1, 1, 1); PG8_STAGE(PG8_SB(1, 0), b3, voffB);
            PG8_BAR; PG8_WAIT_L(0); PG8_MMA(0, 1, At, B1); PG8_BAR;
            PG8_LDA(At, 1, 1); PG8_STAGE(PG8_SA(1, 0), a3, voffA);
            PG8_BAR; PG8_WAIT_L(0); PG8_MMA(1, 0, At, B0); PG8_BAR; PG8_SCHED;
            PG8_STAGE(PG8_SB(1, 1), b3 + hstep, voffB);
            PG8_WAIT_V(6); PG8_BAR; PG8_MMA(1, 1, At, B1); PG8_BAR;
            }
        }
        if constexpr (ALIGN_EPI) { if (wr == 0) PG8_BAR; }
        if constexpr (!Epi::AFTER_DRAIN) { E(acc, cur, wr, wc, fr, fq); S.done(cur); }
        if (!has_next) break;
#pragma unroll
        for (int a = 0; a < 2; ++a)
#pragma unroll
            for (int b = 0; b < 2; ++b)
#pragma unroll
                for (int m = 0; m < 4; ++m)
#pragma unroll
                    for (int n = 0; n < 2; ++n) acc[a][b][m][n] = (f32x4){0.f, 0.f, 0.f, 0.f};
        cur = nxt; cA = nA; cB = nB; ++ui;
        if constexpr (ALIGN_EPI) { if (wr == 1) PG8_BAR; }
    }
    PG8_WAIT_V(0);
    if constexpr (!ALIGN_EPI) { if (wr == 0) PG8_BAR; }
    PG8_BAR;
    if constexpr (Epi::AFTER_DRAIN) { E.fused(acc, cur, wr, wc, fr, fq, lds, wid, lane); S.done(cur); }
#undef PG8_SA
#undef PG8_SB
#undef PG8_STAGE
#undef PG8_LDA
#undef PG8_LDB
#undef PG8_MMA
#undef PG8_WAIT_V
#undef PG8_WAIT_L
#undef PG8_BAR
#undef PG8_SCHED
}
}
#ifndef REPMASK
#define REPMASK 0
#endif
constexpr int NWAVES = 8;
constexpr int D = 1024, MP = 16384, MS = 256, MALL = MP + MS, SEQ = 4096, DR = 1536, NQKVG = 10240;
constexpr float EPS = 1e-6f;
constexpr float LOG2E = 1.4426950408889634f, LN2 = 0.6931471805599453f;
constexpr size_t OFF_YP = 0, OFF_YS = 16777216, OFF_PCONV = 17039360, OFF_PH = 17076224, OFF_PKV0 = 17088512, OFF_PKV1 = 19185664, OFF_PKV2 = 27574272,
                 OFF_SCONV = 61128704, OFF_SH = 61423616, OFF_SKV0 = 61521920, OFF_SKV1 = 62570496, OFF_SKV2 = 63619072, OUT_TOTAL = 64667648;
constexpr size_t MiB = 1u << 20;
constexpr size_t WS_CTL = 0, CTL_ZERO_BYTES = 1 * MiB;
constexpr size_t WS_MOD = 1 * MiB;
constexpr size_t WS_WAT = 3 * MiB, WS_WXT = 4 * MiB;
constexpr size_t WS_AGG = 5 * MiB;
constexpr size_t WS_LSE = 7 * MiB;
constexpr size_t WS_SO = 9 * MiB;
constexpr size_t WS_SLSE = 15 * MiB;
constexpr size_t WS_LWIN = 16 * MiB;
constexpr size_t WS_LWOUT = 28 * MiB;
constexpr size_t WS_AWOUT = 34 * MiB;
constexpr size_t WS_AWIN = 38 * MiB;
constexpr size_t WS_X = 80 * MiB;
constexpr size_t WS_H = 146 * MiB;
constexpr size_t WS_Y = 180 * MiB;
constexpr size_t WS_OACC = 230 * MiB;
constexpr size_t WS_XG = 296 * MiB;
constexpr size_t WS_QS = 616 * MiB;
constexpr size_t WS_SW = 628 * MiB;
constexpr size_t WS_SHB = 636 * MiB;
constexpr size_t CTL_RSS = 524288;
constexpr size_t WS_CARRY = 624 * MiB, CARRY_BYTES = 2 * 64 * 1536 * 16;
#ifndef SEPBUF
#define SEPBUF 0
#endif
constexpr size_t WS_SEP = 700 * MiB;
constexpr size_t WS_END = SEPBUF ? (700 + 1930 + 280) * MiB : 640 * MiB;
constexpr int CW_TMO = 0, CW_BAR = 4096;
constexpr int CW_FIN = 65536, FIN_STRIDE = 32;
constexpr int RING_OFF = 0, RING_BYTES = 131072;
constexpr int LDS_BYTES = 163840;
constexpr int LDSCTL_OFF = LDS_BYTES - 1024, MISC_OFF = LDSCTL_OFF + 320;
constexpr int XPP = 208;
constexpr int ATT_V_OFF = 32768, ATT_VP = 144;

#define GAS __attribute__((address_space(1)))
#define LAS __attribute__((address_space(3)))
typedef unsigned short bf16;
typedef unsigned v4u __attribute__((ext_vector_type(4)));
typedef unsigned v2u __attribute__((ext_vector_type(2)));
typedef float f32x4 __attribute__((ext_vector_type(4)));
typedef float f32x2 __attribute__((ext_vector_type(2)));
typedef short bf16x8 __attribute__((ext_vector_type(8)));
typedef short s16x4 __attribute__((ext_vector_type(4)));
typedef GAS unsigned gu32;
#define RLX_AGENT __ATOMIC_RELAXED, __HIP_MEMORY_SCOPE_AGENT
#define LDS_WAIT() asm volatile("s_waitcnt lgkmcnt(0)" ::: "memory")
typedef float f32x2c_t __attribute__((ext_vector_type(2))); typedef __bf16 bf16x2c_t __attribute__((ext_vector_type(2)));
__device__ __forceinline__ unsigned pk2(float lo, float hi) { const f32x2c_t v = {lo, hi}; const bf16x2c_t b = __builtin_convertvector(v, bf16x2c_t); return __builtin_bit_cast(unsigned, b); }
__device__ __forceinline__ unsigned f2bf(float f) { return pk2(f, 0.f) & 0xffffu; }
__device__ __forceinline__ float bf2f(unsigned b) { return __builtin_bit_cast(float, b << 16); }
__device__ __forceinline__ float bflo(unsigned w) { return __builtin_bit_cast(float, w << 16); }
__device__ __forceinline__ float bfhi(unsigned w) { return __builtin_bit_cast(float, w & 0xffff0000u); }
__device__ __forceinline__ float sigmoid_f(float x) { return __builtin_amdgcn_rcpf(1.f + __builtin_amdgcn_exp2f(-LOG2E * x)); }
__device__ __forceinline__ float silu_f(float x) { return x * sigmoid_f(x); }
#define XB_TMO      128
#define XB_XCNT(j)  (256  + 64 * (j))
#define XB_XSUB(j)  (1280 + 64 * (j))
#define XB_XGEN(j)  (2304 + 64 * (j))
#define XB_TOP      3328
#define XB_TOPGEN   3392
#define XCD_BAR_WORDS 3456
#define XB_SPIN_CAP (1u << 18)

__device__ __forceinline__ unsigned xb_ld(unsigned* p)              { return __hip_atomic_load(p, __ATOMIC_RELAXED, __HIP_MEMORY_SCOPE_AGENT); }
__device__ __forceinline__ unsigned xb_add(unsigned* p, unsigned v) { return __hip_atomic_fetch_add(p, v, __ATOMIC_RELAXED, __HIP_MEMORY_SCOPE_AGENT); }
__device__ __forceinline__ unsigned xb_xcc_id() { return (unsigned)__builtin_amdgcn_s_getreg((3 << 11) | 20) & 0xFu; }
#define XB_SPIN(cond, bar) do { unsigned _sp = 0; while (cond) { __builtin_amdgcn_s_sleep(1); \
    if ((++_sp & 255u) == 0u) { if (xb_ld(&(bar)[XB_TMO])) break; if (_sp > XB_SPIN_CAP) { atomicAdd(&(bar)[XB_TMO], 1u); break; } } } } while (0)

struct XcdBarrier {
    unsigned* bar; unsigned x;
    volatile LAS unsigned* st;
};

__device__ __forceinline__ XcdBarrier xcd_barrier_post(unsigned* bar, volatile LAS unsigned* st) {
    XcdBarrier b; b.bar = bar; b.x = xb_xcc_id(); b.st = st;
    if (threadIdx.x == 0) (void)xb_add(&bar[XB_XCNT(b.x)], 1u);
    return b;
}
__device__ __forceinline__ void xcd_barrier_complete(unsigned* bar, unsigned x, unsigned& nloc, unsigned& nx) {
    const unsigned G = gridDim.x * gridDim.y * gridDim.z;
    unsigned sum, cnt, mine, sp = 0u;
    for (;;) {
        sum = 0u; cnt = 0u; mine = 0u;
#pragma unroll
        for (unsigned j = 0; j < 16; ++j) { const unsigned c = xb_ld(&bar[XB_XCNT(j)]); sum += c; cnt += (c > 0u) ? 1u : 0u; mine = (j == x) ? c : mine; }
        if (sum == G) break;
        __builtin_amdgcn_s_sleep(1);
        if ((++sp & 255u) == 0u) { if (xb_ld(&bar[XB_TMO])) break; if (sp > XB_SPIN_CAP) { atomicAdd(&bar[XB_TMO], 1u); break; } }
    }
    nloc = mine > 0u ? mine : 1u; nx = cnt > 0u ? cnt : 1u;
}

__device__ __forceinline__ void xcd_barrier(const XcdBarrier& b) {
    asm volatile("s_waitcnt vmcnt(0)" ::: "memory");
    __syncthreads();
    if (threadIdx.x == 0) {
        unsigned* bar = b.bar;
        __builtin_amdgcn_s_waitcnt(0);
        unsigned nloc = b.st[0], nx = b.st[1];
        if (nloc == 0u) { xcd_barrier_complete(bar, b.x, nloc, nx); b.st[0] = nloc; b.st[1] = nx; }
        const unsigned old = xb_add(&bar[XB_XSUB(b.x)], 1u);
        const unsigned gen = old / nloc;
        if (old + 1u == (gen + 1u) * nloc) {
            __builtin_amdgcn_fence(__ATOMIC_RELEASE, "agent");
            asm volatile("s_waitcnt vmcnt(0)" ::: "memory");
            const unsigned og = xb_add(&bar[XB_TOP], 1u);
            const unsigned tg = og / nx;
            if (og + 1u == (tg + 1u) * nx) xb_add(&bar[XB_TOPGEN], 1u);
            else XB_SPIN(xb_ld(&bar[XB_TOPGEN]) == tg, bar);
            __builtin_amdgcn_fence(__ATOMIC_ACQUIRE, "agent");
            xb_add(&bar[XB_XGEN(b.x)], 1u);
            asm volatile("s_waitcnt vmcnt(0)" ::: "memory");
        } else {
            XB_SPIN(xb_ld(&bar[XB_XGEN(b.x)]) == gen, bar);
            __builtin_amdgcn_fence(__ATOMIC_ACQUIRE, "agent");
            asm volatile("s_waitcnt vmcnt(0)" ::: "memory");
        }
    }
    __syncthreads();
}
__device__ __forceinline__ const void* launder_ptr(const void* p) {
    unsigned lo = (unsigned)(unsigned long long)p, hi = (unsigned)((unsigned long long)p >> 32);
    asm volatile("" : "+v"(lo), "+v"(hi));
    lo = __builtin_amdgcn_readfirstlane(lo); hi = __builtin_amdgcn_readfirstlane(hi);
    return (const void*)(((unsigned long long)hi << 32) | lo);
}
struct Args { const float* in[24]; float* outp; unsigned char* ws; int ph_lo, ph_hi; };
struct Frame {
    LAS unsigned char* lds;
    volatile LAS unsigned* MISC;
    int tid, vcu, G;
    int sA, sO;
    const __attribute__((address_space(4))) Args* A; unsigned char* ws;
    __device__ __forceinline__ float* out() const { return A->outp; }
    __device__ __forceinline__ gu32* ctl() const { return (gu32*)(ws + WS_CTL); }
    __device__ __forceinline__ const float* x_prompt() const { return A->in[0]; }
    __device__ __forceinline__ const float* x_sample() const { return A->in[1]; }
    __device__ __forceinline__ const float* state_conv() const { return A->in[2]; }
    __device__ __forceinline__ const float* state_h() const { return A->in[3]; }
    __device__ __forceinline__ const float* cache0() const { return A->in[4]; }
    __device__ __forceinline__ const float* cache1() const { return A->in[5]; }
    __device__ __forceinline__ const float* cache2() const { return A->in[6]; }
    __device__ __forceinline__ const float* c_prompt() const { return A->in[7]; }
    __device__ __forceinline__ const float* c_sample() const { return A->in[8]; }
    __device__ __forceinline__ const float* norm_g() const { return A->in[9]; }
    __device__ __forceinline__ const float* ada_w() const { return A->in[10]; }
    __device__ __forceinline__ const float* ada_b() const { return A->in[11]; }
    __device__ __forceinline__ const float* final_g() const { return A->in[12]; }
    __device__ __forceinline__ const float* lru_w_in() const { return A->in[13]; }
    __device__ __forceinline__ const float* lru_conv_w() const { return A->in[14]; }
    __device__ __forceinline__ const float* lru_conv_b() const { return A->in[15]; }
    __device__ __forceinline__ const float* lru_wa() const { return A->in[16]; }
    __device__ __forceinline__ const float* lru_ba() const { return A->in[17]; }
    __device__ __forceinline__ const float* lru_wx() const { return A->in[18]; }
    __device__ __forceinline__ const float* lru_bx() const { return A->in[19]; }
    __device__ __forceinline__ const float* lru_lambda() const { return A->in[20]; }
    __device__ __forceinline__ const float* lru_w_out() const { return A->in[21]; }
    __device__ __forceinline__ const float* att_w_in() const { return A->in[22]; }
    __device__ __forceinline__ const float* att_w_out() const { return A->in[23]; }
    __device__ __forceinline__ float* mod() const { return (float*)(ws + WS_MOD); }
    __device__ __forceinline__ bf16* wa_t() const { return (bf16*)(ws + WS_WAT); }
    __device__ __forceinline__ bf16* wx_t() const { return (bf16*)(ws + WS_WXT); }
    __device__ __forceinline__ f32x2* agg() const { return (f32x2*)(ws + WS_AGG); }
    __device__ __forceinline__ float* lse() const { return (float*)(ws + (SEPBUF ? WS_SEP + 1870 * MiB + (size_t)sO * (2 * MiB) : WS_LSE)); }
    __device__ __forceinline__ bf16* lwin_t() const { return (bf16*)(ws + WS_LWIN); }
    __device__ __forceinline__ bf16* lwout_t() const { return (bf16*)(ws + WS_LWOUT); }
    __device__ __forceinline__ bf16* awin_t() const { return (bf16*)(ws + WS_AWIN); }
    __device__ __forceinline__ bf16* awout_t() const { return (bf16*)(ws + WS_AWOUT); }
    __device__ __forceinline__ bf16* HN() const { return (bf16*)(ws + (SEPBUF ? WS_SEP + (size_t)(sA + 1) * (36 * MiB) : WS_H)); }
    __device__ __forceinline__ float* SW(int layer) const { return (float*)(ws + WS_SW) + (size_t)layer * 36 * 10240; }
    __device__ __forceinline__ bf16* SHB(int layer) const { return (bf16*)(ws + WS_SHB) + (size_t)layer * 256 * 1024; }
    __device__ __forceinline__ float* RSS(int layer) const { return (float*)(ws + WS_CTL + CTL_RSS) + (size_t)layer * MALL; }
    __device__ __forceinline__ unsigned long long* carry() const { return (unsigned long long*)(ws + WS_CARRY); }
    __device__ __forceinline__ float* X() const { return (float*)(ws + WS_X); }
    __device__ __forceinline__ float* XL(int layer) const { return (float*)(ws + (SEPBUF ? WS_SEP + 1930 * MiB + (size_t)layer * (70 * MiB) : WS_X)); }
    __device__ __forceinline__ bf16* H() const { return (bf16*)(ws + (SEPBUF ? WS_SEP + (size_t)sA * (36 * MiB) : WS_H)); }
    __device__ __forceinline__ bf16* Y() const { return (bf16*)(ws + (SEPBUF ? WS_SEP + 1500 * MiB + (size_t)sA * (52 * MiB) : WS_Y)); }
    __device__ __forceinline__ float* OACC() const { return (float*)(ws + (SEPBUF ? WS_SEP + 1720 * MiB + (size_t)sO * (70 * MiB) : WS_OACC)); }
    __device__ __forceinline__ bf16* XG() const { return (bf16*)(ws + (SEPBUF ? WS_SEP + 160 * MiB + (size_t)sA * (330 * MiB) : WS_XG)); }
    __device__ __forceinline__ bf16* QS() const { return (bf16*)(ws + (SEPBUF ? WS_SEP + 1910 * MiB + (size_t)sO * (6 * MiB) : WS_QS)); }
    __device__ __forceinline__ float* SO() const { return (float*)(ws + (SEPBUF ? WS_SEP + 1880 * MiB + (size_t)sO * (8 * MiB) : WS_SO)); }
    __device__ __forceinline__ float* SLSE() const { return (float*)(ws + (SEPBUF ? WS_SEP + 1900 * MiB + (size_t)sO * (1 * MiB) : WS_SLSE)); }
};

__device__ __forceinline__ void glds16(const void* gsrc, unsigned lds_dst) { unsigned keep;
    asm volatile("s_mov_b32 %0, m0\n\ts_mov_b32 m0, %2\n\ts_nop 0\n\tglobal_load_lds_dwordx4 %1, off\n\ts_mov_b32 m0, %0" : "=&s"(keep) : "v"(gsrc), "s"(lds_dst) : "memory"); }
__device__ __forceinline__ float shx(float v, int lane, int k) { return __builtin_bit_cast(float, __builtin_amdgcn_ds_bpermute((lane ^ k) << 2, __builtin_bit_cast(int, v))); }
__device__ __forceinline__ float shup(float v, int lane, int k) { const int src = lane >= k ? lane - k : lane; return __builtin_bit_cast(float, __builtin_amdgcn_ds_bpermute(src << 2, __builtin_bit_cast(int, v))); }
__device__ __forceinline__ float shl(float v, int src) { return __builtin_bit_cast(float, __builtin_amdgcn_ds_bpermute(src << 2, __builtin_bit_cast(int, v))); }
__device__ __forceinline__ float wave_sum(float v, int lane) {
#pragma unroll
    for (int o = 1; o < 64; o <<= 1) v += shx(v, lane, o);
    return v;
}
__device__ __forceinline__ void p0_transpose_item(const float* W, int K, int N, bf16* WT, LAS float* scr, int item, int lane) {
    const int nblk = N / 32, kb = item / nblk, nb = item % nblk, k0 = 64 * kb, n0 = 32 * nb;
    float wv[32];
#pragma unroll
    for (int i = 0; i < 32; ++i) { const int kk = 2 * i + (lane >> 5); wv[i] = W[(size_t)(k0 + kk) * N + n0 + (lane & 31)]; }
#pragma unroll
    for (int i = 0; i < 32; ++i) { const int kk = 2 * i + (lane >> 5); scr[kk * 33 + (lane & 31)] = wv[i]; }
    LDS_WAIT(); asm volatile("" ::: "memory");
    const int c = lane & 7;
#pragma unroll
    for (int j = 0; j < 4; ++j) { const int n = (lane >> 3) + 8 * j; const LAS float* s = scr + (8 * c) * 33 + n;
        v4u o; o.x = pk2(s[0 * 33], s[1 * 33]); o.y = pk2(s[2 * 33], s[3 * 33]); o.z = pk2(s[4 * 33], s[5 * 33]); o.w = pk2(s[6 * 33], s[7 * 33]);
        *(GAS v4u*)(WT + (size_t)(n0 + n) * K + k0 + 8 * c) = o; }
    LDS_WAIT(); asm volatile("" ::: "memory");
}

constexpr int CV_LIN = 16 * 96, CV_LOUT = CV_LIN + 24 * 32, CV_AIN = CV_LOUT + 16 * 320, CV_AOUT = CV_AIN + 16 * 32;
__device__ __forceinline__ void conv_items(Frame& F, int j, int lo, int hi, int rank, int nrank) {
    int tid_ = F.tid; asm volatile("" : "+v"(tid_));
    const int lane = tid_ & 63, wave = __builtin_amdgcn_readfirstlane(tid_ >> 6), wk = rank * NWAVES + wave, nwk = nrank * NWAVES;
    LAS float* scr = (LAS float*)(F.lds + RING_OFF + wave * 16384);
    for (int it = lo + wk; it < hi; it += nwk) {
        if (it < CV_LIN) p0_transpose_item(F.lru_w_in() + (size_t)j * 1024 * 3072, 1024, 3072, F.lwin_t() + (size_t)j * 3072 * 1024, scr, it, lane);
        else if (it < CV_LOUT) p0_transpose_item(F.lru_w_out() + (size_t)j * 1536 * 1024, 1536, 1024, F.lwout_t() + (size_t)j * 1024 * 1536, scr, it - CV_LIN, lane);
        else if (it < CV_AIN) p0_transpose_item(F.att_w_in() + (size_t)j * 1024 * 10240, 1024, 10240, F.awin_t() + (size_t)j * 10240 * 1024, scr, it - CV_LOUT, lane);
        else p0_transpose_item(F.att_w_out() + (size_t)j * 1024 * 1024, 1024, 1024, F.awout_t() + (size_t)j * 1024 * 1024, scr, it - CV_AIN, lane);
    }
}
__device__ __forceinline__ void p0_prologue(Frame& F) {
    LAS float* L = (LAS float*)(F.lds + RING_OFF);
    int tid_ = F.tid; asm volatile("" : "+v"(tid_));
    const int tid = tid_, p_lane = tid & 63, p_wave = __builtin_amdgcn_readfirstlane(tid >> 6);
    for (int u = F.vcu; u < 192; u += F.G) {
        const int layer = u / 48, n0 = (u % 48) * 64, col = tid & 63, kg = tid >> 6;
        float acc[36];
#pragma unroll
        for (int r = 0; r < 36; ++r) acc[r] = 0.f;
        for (int kh = 0; kh < 2; ++kh) {
            __syncthreads();
            { const int k = kh * 512 + tid;
#pragma unroll 4
              for (int r = 0; r < 36; ++r) { const float cv = (r < 4) ? F.c_prompt()[r * 1024 + k] : F.c_sample()[(r - 4) * 1024 + k]; L[tid * 36 + r] = silu_f(cv); } }
            __syncthreads();
            const float* wp = F.ada_w() + ((size_t)layer * 1024 + kh * 512 + kg * 64) * 3072 + n0 + col;
#pragma unroll 2
            for (int kl = 0; kl < 64; ++kl) { const float w = wp[(size_t)kl * 3072]; const LAS f32x4* s4 = (const LAS f32x4*)(L + (kg * 64 + kl) * 36);
#pragma unroll
                for (int q = 0; q < 9; ++q) { const f32x4 s = s4[q]; acc[4 * q] += s.x * w; acc[4 * q + 1] += s.y * w; acc[4 * q + 2] += s.z * w; acc[4 * q + 3] += s.w * w; } }
        }
        __syncthreads();
#pragma unroll
        for (int r = 0; r < 36; ++r) L[(kg * 36 + r) * 64 + col] = acc[r];
        __syncthreads();
        for (int o = tid; o < 36 * 64; o += 512) { const int r = o >> 6, c = o & 63; float s = F.ada_b()[layer * 3072 + n0 + c];
#pragma unroll
            for (int g = 0; g < 8; ++g) s += L[(g * 36 + r) * 64 + c];
            F.mod()[((size_t)layer * 36 + r) * 3072 + n0 + c] = s;
            if (n0 < 1024) F.SHB(layer)[(size_t)r * 1024 + n0 + c] = (bf16)f2bf(s); }
        __syncthreads();
    }
    for (int e = F.vcu * 512 + tid; e < 2 * 16 * 9216; e += F.G * 512) { const int blk = e / 9216, rem = e % 9216, jj = rem / 96, i = rem % 96;
        F.wa_t()[e] = (bf16)f2bf(F.lru_wa()[(size_t)blk * 9216 + i * 96 + jj]); F.wx_t()[e] = (bf16)f2bf(F.lru_wx()[(size_t)blk * 9216 + i * 96 + jj]); }
    conv_items(F, 0, 0, CV_LIN, F.vcu, F.G);
}

__device__ __forceinline__ void norm_phase(Frame& F, int layer) {
    int tid_ = F.tid; asm volatile("" : "+v"(tid_));
    const int lane = tid_ & 63, wave = __builtin_amdgcn_readfirstlane(tid_ >> 6);
    const int gw = F.vcu * NWAVES + wave, NGW = F.G * NWAVES;
    const float* gp = F.norm_g() + layer * 1024; const float* mod = F.mod() + (size_t)layer * 36 * 3072;
    for (int m0 = gw; m0 < MALL; m0 += 2 * NGW) {
        const int m1 = (m0 + NGW < MALL) ? m0 + NGW : m0;
        f32x4 v[2][4];
#pragma unroll
        for (int r = 0; r < 2; ++r) { const int m = r ? m1 : m0; const bool sm = m >= MP;
            const float* xrow = (layer == 0) ? (sm ? F.x_sample() + (size_t)(m - MP) * 1024 : F.x_prompt() + (size_t)m * 1024) : F.XL(layer - 1) + (size_t)m * 1024;
            const GAS f32x4* xr = (const GAS f32x4*)xrow + lane;
#pragma unroll
            for (int q = 0; q < 4; ++q) v[r][q] = xr[64 * q]; }
#pragma unroll
        for (int r = 0; r < 2; ++r) { const int m = r ? m1 : m0; const bool sm = m >= MP; const int mr = sm ? 4 + ((m - MP) >> 3) : (m >> 12);
            float s = 0.f;
#pragma unroll
            for (int q = 0; q < 4; ++q) s += (v[r][q].x * v[r][q].x + v[r][q].y * v[r][q].y) + (v[r][q].z * v[r][q].z + v[r][q].w * v[r][q].w);
            const float rstd = rsqrtf(wave_sum(s, lane) * (1.f / 1024.f) + EPS);
            const float* mrow = mod + (size_t)mr * 3072;
            GAS v2u* o8 = (GAS v2u*)(F.H() + (size_t)m * 1024) + lane;
#pragma unroll
            for (int q = 0; q < 4; ++q) { const int c = 4 * lane + 256 * q;
                const f32x4 g4 = *(const f32x4*)(gp + c), sh = *(const f32x4*)(mrow + c), sc = *(const f32x4*)(mrow + 1024 + c);
                const f32x4 h = v[r][q] * rstd * g4 * (sc + 1.f) + sh;
                v2u w; w.x = pk2(h.x, h.y); w.y = pk2(h.z, h.w); o8[64 * q] = w; } }
    }
}
__device__ __forceinline__ void final_phase(Frame& F) {
    int tid_ = F.tid; asm volatile("" : "+v"(tid_));
    const int lane = tid_ & 63, wave = __builtin_amdgcn_readfirstlane(tid_ >> 6);
    const int gw = F.vcu * NWAVES + wave, NGW = F.G * NWAVES;
    for (int m0 = gw; m0 < MALL; m0 += 2 * NGW) {
        const int m1 = (m0 + NGW < MALL) ? m0 + NGW : m0;
        f32x4 v[2][4];
#pragma unroll
        for (int r = 0; r < 2; ++r) { const GAS f32x4* xr = (const GAS f32x4*)(F.XL(3) + (size_t)(r ? m1 : m0) * 1024) + lane;
#pragma unroll
            for (int q = 0; q < 4; ++q) v[r][q] = xr[64 * q]; }
#pragma unroll
        for (int r = 0; r < 2; ++r) { float s = 0.f;
#pragma unroll
            for (int q = 0; q < 4; ++q) s += (v[r][q].x * v[r][q].x + v[r][q].y * v[r][q].y) + (v[r][q].z * v[r][q].z + v[r][q].w * v[r][q].w);
            const float rstd = rsqrtf(wave_sum(s, lane) * (1.f / 1024.f) + EPS);
            GAS f32x4* o = (GAS f32x4*)(F.out() + (size_t)(r ? m1 : m0) * 1024) + lane;
#pragma unroll
            for (int q = 0; q < 4; ++q) { const f32x4 g4 = *(const f32x4*)(F.final_g() + 4 * lane + 256 * q); o[64 * q] = v[r][q] * rstd * g4; } }
    }
}

namespace pg8 {
constexpr int MPROMPT = 16384;
struct EpiResid {
    static constexpr bool PERM = true, AFTER_DRAIN = false, PREFETCH = true;
    const Frame& F; int l; bool hasnext;
    __device__ __forceinline__ void prefetch(const Unit& u, int i, int wid, int wr, int wc, int lane) const {
        const float* xin = (l == 0) ? F.x_prompt() : F.XL(l - 1);
        const float* base = xin + (size_t)(u.pm * BM + wr * 64 + (i >> 2) * HALF + 16 * (i & 3)) * 1024 + u.pn * BM + wc * 32;
        const unsigned voff = (unsigned)(lane >> 2) * 4096u + (unsigned)((lane >> 1) & 1) * 512u + (unsigned)(lane & 1) * 64u;
        const unsigned dst = (unsigned)(size_t)(F.lds + RING_BYTES) + (unsigned)wid * 1024u; unsigned keep;
        asm volatile("s_mov_b32 %0, m0\n\ts_mov_b32 m0, %3\n\ts_nop 0\n\tglobal_load_lds_dwordx4 %1, %2\n\ts_mov_b32 m0, %0" : "=&s"(keep) : "v"(voff), "s"(base), "s"(dst) : "memory");
    }
    __device__ __forceinline__ void operator()(const f32x4 (&acc)[2][2][4][2], const Unit& u, int wr, int wc, int fr, int fq) const {
        const float* xin = (l == 0) ? F.x_prompt() : F.XL(l - 1); float* xout = F.XL(l); const float* gate = F.mod() + (size_t)l * 36 * 3072 + 2048;
        bf16_t* hn = hasnext ? F.HN() : nullptr; const float* gnext = F.norm_g() + (l + 1) * 1024; const float* scnext = F.mod() + (size_t)(l + 1) * 36 * 3072 + 1024; float* rss = F.RSS(hasnext ? l + 1 : 0);
        const int row0 = u.pm * BM + wr * 64 + fr, col0 = u.pn * BM + wc * 32 + 8 * fq;
        const int mr = row0 >> 12;
        float ss[2][4];
#pragma unroll
        for (int ai = 0; ai < 2; ++ai)
#pragma unroll
            for (int m = 0; m < 4; ++m) ss[ai][m] = 0.f;
#pragma unroll
        for (int bj = 0; bj < 2; ++bj) { const int c = col0 + bj * HALF;
            const f32x4 g0 = *(const f32x4*)(gate + (size_t)mr * 3072 + c), g1 = *(const f32x4*)(gate + (size_t)mr * 3072 + c + 4);
            f32x4 m0 = g0, m1 = g1;
            if (hn) { const f32x4 a0 = *(const f32x4*)(gnext + c), a1 = *(const f32x4*)(gnext + c + 4), s0 = *(const f32x4*)(scnext + (size_t)mr * 3072 + c), s1 = *(const f32x4*)(scnext + (size_t)mr * 3072 + c + 4);
                m0 = a0 * (s0 + 1.f); m1 = a1 * (s1 + 1.f); }
#pragma unroll
            for (int ai = 0; ai < 2; ++ai)
#pragma unroll
              for (int mh = 0; mh < 2; ++mh) {
                f32x4 xo[2][2];
#pragma unroll
                for (int mm = 0; mm < 2; ++mm) { const size_t ro = (size_t)(row0 + ai * HALF + (2 * mh + mm) * 16) * 1024 + c; xo[mm][0] = *(const f32x4*)(xin + ro); xo[mm][1] = *(const f32x4*)(xin + ro + 4); }
#pragma unroll
                for (int mm = 0; mm < 2; ++mm) asm volatile("" : "+v"(xo[mm][0]), "+v"(xo[mm][1]));
#pragma unroll
                for (int mm = 0; mm < 2; ++mm) { const int m = 2 * mh + mm; const size_t ro = (size_t)(row0 + ai * HALF + m * 16) * 1024 + c;
                    const f32x4 x0 = xo[mm][0] + g0 * acc[ai][bj][m][0], x1 = xo[mm][1] + g1 * acc[ai][bj][m][1];
                    *(f32x4*)(xout + ro) = x0; *(f32x4*)(xout + ro + 4) = x1;
                    if (hn) { ss[ai][m] += (x0[0] * x0[0] + x0[1] * x0[1]) + (x0[2] * x0[2] + x0[3] * x0[3]) + (x1[0] * x1[0] + x1[1] * x1[1]) + (x1[2] * x1[2] + x1[3] * x1[3]);
                        const f32x4 h0 = x0 * m0, h1 = x1 * m1;
                        u32x4 w; w.x = cvt_pk_bf16(h0[0], h0[1]); w.y = cvt_pk_bf16(h0[2], h0[3]); w.z = cvt_pk_bf16(h1[0], h1[1]); w.w = cvt_pk_bf16(h1[2], h1[3]);
                        *(u32x4*)(hn + ro) = w; } } } }
        if (hn) {
#pragma unroll
            for (int ai = 0; ai < 2; ++ai)
#pragma unroll
                for (int m = 0; m < 4; ++m) { float v = ss[ai][m]; const int ln = fr + 16 * fq;
                    v += __builtin_bit_cast(float, __builtin_amdgcn_ds_bpermute((ln ^ 16) << 2, __builtin_bit_cast(int, v))); v += __builtin_bit_cast(float, __builtin_amdgcn_ds_bpermute((ln ^ 32) << 2, __builtin_bit_cast(int, v)));
                    if (fq == 0) atomicAdd(rss + row0 + ai * HALF + m * 16, v); } }
    }
};
struct EpiFinal {
    static constexpr bool PERM = true, AFTER_DRAIN = true, PREFETCH = true;
    const Frame& F; int l;
    __device__ __forceinline__ void prefetch(const Unit& u, int i, int wid, int wr, int wc, int lane) const {
        const float* xin = F.XL(l - 1);
        const float* base = xin + (size_t)(u.pm * BM + wr * 64 + (i >> 2) * HALF + 16 * (i & 3)) * 1024 + u.pn * BM + wc * 32;
        const unsigned voff = (unsigned)(lane >> 2) * 4096u + (unsigned)((lane >> 1) & 1) * 512u + (unsigned)(lane & 1) * 64u;
        const unsigned dst = (unsigned)(size_t)(F.lds + RING_BYTES) + (unsigned)wid * 1024u; unsigned keep;
        asm volatile("s_mov_b32 %0, m0\n\ts_mov_b32 m0, %3\n\ts_nop 0\n\tglobal_load_lds_dwordx4 %1, %2\n\ts_mov_b32 m0, %0" : "=&s"(keep) : "v"(voff), "s"(base), "s"(dst) : "memory");
    }
    template <class L> __device__ __forceinline__ void fused(f32x4 (&acc)[2][2][4][2], const Unit& u, int wr, int wc, int fr, int fq, L lds, int wid, int lane) const {
        const LAS unsigned char* park = (const LAS unsigned char*)lds + (unsigned)(wid * 64 + lane) * 16u;
        const float* xin = F.XL(l - 1); const float* gate = F.mod() + (size_t)l * 36 * 3072 + 2048; float* rss = F.RSS(0);
        int row0 = u.pm * BM + wr * 64 + fr, col0 = u.pn * BM + wc * 32 + 8 * fq;
        asm volatile("" : "+v"(row0), "+v"(col0));
        const int mr = row0 >> 12;
        float ss[2][4];
#pragma unroll
        for (int ai = 0; ai < 2; ++ai)
#pragma unroll
            for (int m = 0; m < 4; ++m) ss[ai][m] = 0.f;
#pragma unroll
        for (int bj = 0; bj < 2; ++bj) { const int c = col0 + bj * HALF;
            const f32x4 g0 = *(const f32x4*)(gate + (size_t)mr * 3072 + c), g1 = *(const f32x4*)(gate + (size_t)mr * 3072 + c + 4);
#pragma unroll
            for (int ai = 0; ai < 2; ++ai)
#pragma unroll
              for (int mh = 0; mh < 2; ++mh) {
                f32x4 xo[2][2];
#pragma unroll
                for (int mm = 0; mm < 2; ++mm) { const size_t ro = (size_t)(row0 + ai * HALF + (2 * mh + mm) * 16) * 1024 + c; xo[mm][0] = *(const f32x4*)(xin + ro); xo[mm][1] = *(const f32x4*)(xin + ro + 4); }
#pragma unroll
                for (int mm = 0; mm < 2; ++mm) asm volatile("" : "+v"(xo[mm][0]), "+v"(xo[mm][1]));
#pragma unroll
                for (int mm = 0; mm < 2; ++mm) { const int m = 2 * mh + mm;
                    const f32x4 x0 = xo[mm][0] + g0 * acc[ai][bj][m][0], x1 = xo[mm][1] + g1 * acc[ai][bj][m][1];
                    if (bj == 0) { acc[ai][0][m][0] = x0; acc[ai][0][m][1] = x1; }
                    else { *(LAS f32x4*)(park + ((ai * 4 + m) * 2 + 0) * 8192) = x0; *(LAS f32x4*)(park + ((ai * 4 + m) * 2 + 1) * 8192) = x1; }
                    ss[ai][m] += (x0[0] * x0[0] + x0[1] * x0[1]) + (x0[2] * x0[2] + x0[3] * x0[3]) + (x1[0] * x1[0] + x1[1] * x1[1]) + (x1[2] * x1[2] + x1[3] * x1[3]); }
                asm volatile("" ::: "memory"); } }
        const int ln = fr + 16 * fq; float got = 0.f;
#pragma unroll
        for (int ai = 0; ai < 2; ++ai)
#pragma unroll
            for (int m = 0; m < 4; ++m) { float v = ss[ai][m];
                v += __builtin_bit_cast(float, __builtin_amdgcn_ds_bpermute((ln ^ 16) << 2, __builtin_bit_cast(int, v))); v += __builtin_bit_cast(float, __builtin_amdgcn_ds_bpermute((ln ^ 32) << 2, __builtin_bit_cast(int, v)));
                ss[ai][m] = v; }
        if (fq == 0) { float r[2][4];
#pragma unroll
            for (int ai = 0; ai < 2; ++ai)
#pragma unroll
                for (int m = 0; m < 4; ++m) r[ai][m] = atomicAdd(rss + row0 + ai * HALF + m * 16, ss[ai][m]);
#pragma unroll
            for (int ai = 0; ai < 2; ++ai)
#pragma unroll
                for (int m = 0; m < 4; ++m) asm volatile("" : "+v"(r[ai][m]));
            got = r[0][0]; }
        asm volatile("s_waitcnt vmcnt(0)" : "+v"(got) :: "memory");
        gu32* cnt = F.ctl() + CW_FIN + u.pm * FIN_STRIDE;
        if (ln == 0) __hip_atomic_fetch_add(cnt, 1u, RLX_AGENT);
        for (int it = 0; it < (1 << 20); ++it) { if (__hip_atomic_load(cnt, RLX_AGENT) >= 32u) break; __builtin_amdgcn_s_sleep(2); }
        asm volatile("" : "+v"(row0), "+v"(col0));
        float rs[2][4];
#pragma unroll
        for (int ai = 0; ai < 2; ++ai)
#pragma unroll
            for (int m = 0; m < 4; ++m) rs[ai][m] = __hip_atomic_load(rss + row0 + ai * HALF + m * 16, RLX_AGENT);
#pragma unroll
        for (int ai = 0; ai < 2; ++ai)
#pragma unroll
            for (int m = 0; m < 4; ++m) rs[ai][m] = __builtin_amdgcn_rsqf(rs[ai][m] * (1.f / 1024.f) + 1e-6f);
        float* out = F.out(); const float* fg = F.final_g();
#pragma unroll
        for (int bj = 0; bj < 2; ++bj) { const int c = col0 + bj * HALF;
            const f32x4 f0 = *(const f32x4*)(fg + c), f1 = *(const f32x4*)(fg + c + 4);
#pragma unroll
            for (int ai = 0; ai < 2; ++ai)
#pragma unroll
                for (int m = 0; m < 4; ++m) { const size_t ro = (size_t)(row0 + ai * HALF + m * 16) * 1024 + c;
                    f32x4 x0, x1;
                    if (bj == 0) { x0 = acc[ai][0][m][0]; x1 = acc[ai][0][m][1]; }
                    else { x0 = *(const LAS f32x4*)(park + ((ai * 4 + m) * 2 + 0) * 8192); x1 = *(const LAS f32x4*)(park + ((ai * 4 + m) * 2 + 1) * 8192); }
                    *(f32x4*)(out + ro) = x0 * rs[ai][m] * f0; *(f32x4*)(out + ro + 4) = x1 * rs[ai][m] * f1; } }
    }
};
struct EpiXg {
    static constexpr bool PERM = true, AFTER_DRAIN = false, PREFETCH = false;
    const Frame& F; int l; bool fused; int mall;
    __device__ __forceinline__ void operator()(const f32x4 (&acc)[2][2][4][2], const Unit& u, int wr, int wc, int fr, int fq) const {
        bf16_t* O = F.XG(); const float* rss = fused ? F.RSS(l) : nullptr; const float* sw = F.SW(l);
        const int row0 = u.pm * BM + wr * 64 + fr, col0 = u.pn * BM + wc * 32 + 8 * fq;
        float rs[2][4];
#pragma unroll
        for (int ai = 0; ai < 2; ++ai)
#pragma unroll
            for (int m = 0; m < 4; ++m) rs[ai][m] = rss ? rss[row0 + ai * HALF + m * 16] : 1024.f;
        f32x4 wsw[2][2];
#pragma unroll
        for (int bj = 0; bj < 2; ++bj) { wsw[bj][0] = (f32x4){0.f, 0.f, 0.f, 0.f}; wsw[bj][1] = wsw[bj][0];
            if (rss) { const float* sp = sw + (size_t)(row0 >> 12) * 3072 + col0 + bj * HALF; wsw[bj][0] = *(const f32x4*)sp; wsw[bj][1] = *(const f32x4*)(sp + 4); } }
#pragma unroll
        for (int ai = 0; ai < 2; ++ai)
#pragma unroll
            for (int m = 0; m < 4; ++m) rs[ai][m] = rss ? __builtin_amdgcn_rsqf(rs[ai][m] * (1.f / 1024.f) + 1e-6f) : 1.f;
#pragma unroll
        for (int bj = 0; bj < 2; ++bj) { const int c = col0 + bj * HALF, nb2 = c / 96, cin = c - nb2 * 96;
            bf16_t* cb = O + ((size_t)nb2 * mall) * 96 + cin;
            const f32x4 w0 = wsw[bj][0], w1 = wsw[bj][1];
#pragma unroll
            for (int ai = 0; ai < 2; ++ai)
#pragma unroll
                for (int m = 0; m < 4; ++m) { const int row = row0 + ai * HALF + m * 16; const f32x4 v0 = acc[ai][bj][m][0] * rs[ai][m] + w0, v1 = acc[ai][bj][m][1] * rs[ai][m] + w1;
                    u32x4 w; w.x = cvt_pk_bf16(v0[0], v0[1]); w.y = cvt_pk_bf16(v0[2], v0[3]); w.z = cvt_pk_bf16(v1[0], v1[1]); w.w = cvt_pk_bf16(v1[2], v1[3]);
                    *(u32x4*)(cb + (size_t)row * 96) = w; } }
    }
};
struct EpiQkv {
    static constexpr bool PERM = true, AFTER_DRAIN = false, PREFETCH = false;
    const Frame& F; int l; int j;
    __device__ __forceinline__ void operator()(const f32x4 (&acc)[2][2][4][2], const Unit& u, int wr, int wc, int fr, int fq) const {
        bf16_t* O = F.XG(); float* out = F.out(); const float* rss = F.RSS(l); const float* sw = F.SW(l);
        const int row0 = u.pm * BM + wr * 64 + fr; const int colt = u.pn * BM;
        const int gp = colt >> 10, g = gp / 3, part = gp - 3 * g;
        const int ld = (gp == 9) ? 4 : 2 * g;
        const bool kv = (gp < 9) && (part >= 1);
        const int W = 128 << (2 * g);
        const size_t offp = (g == 0) ? 17088512u : (g == 1) ? 19185664u : 27574272u;
        const int hd0 = (colt & 1023) + wc * 32 + 8 * fq;
        bf16_t* rbase = O + (size_t)gp * 16777216u + (size_t)(row0 >> 12) * 4194304u;
        float rs[2][4];
#pragma unroll
        for (int ai = 0; ai < 2; ++ai)
#pragma unroll
            for (int m = 0; m < 4; ++m) rs[ai][m] = rss[row0 + ai * HALF + m * 16];
        f32x4 wsw[2][2];
#pragma unroll
        for (int bj = 0; bj < 2; ++bj) { const float* sp = sw + (size_t)(row0 >> 12) * 10240 + colt + wc * 32 + 8 * fq + bj * HALF; wsw[bj][0] = *(const f32x4*)sp; wsw[bj][1] = *(const f32x4*)(sp + 4); }
#pragma unroll
        for (int ai = 0; ai < 2; ++ai)
#pragma unroll
            for (int m = 0; m < 4; ++m) rs[ai][m] = __builtin_amdgcn_rsqf(rs[ai][m] * (1.f / 1024.f) + 1e-6f);
#pragma unroll
        for (int bj = 0; bj < 2; ++bj) { const int hd = hd0 + bj * HALF;
            const f32x4 w0 = wsw[bj][0], w1 = wsw[bj][1];
#pragma unroll
            for (int ai = 0; ai < 2; ++ai)
#pragma unroll
                for (int m = 0; m < 4; ++m) { const int row = row0 + ai * HALF + m * 16; const int t = row & 4095;
                    const int pp = ((t & ((1 << ld) - 1)) << (12 - ld)) | (t >> ld);
                    const f32x4 v0 = acc[ai][bj][m][0] * rs[ai][m] + w0, v1 = acc[ai][bj][m][1] * rs[ai][m] + w1;
                    u32x4 w; w.x = cvt_pk_bf16(v0[0], v0[1]); w.y = cvt_pk_bf16(v0[2], v0[3]); w.z = cvt_pk_bf16(v1[0], v1[1]); w.w = cvt_pk_bf16(v1[2], v1[3]);
                    *(u32x4*)(rbase + ((size_t)((hd >> 6) * 4096 + pp)) * 64 + (hd & 63)) = w;
                    if (kv && t >= 4096 - W) { float* kvp = out + offp + ((size_t)((j * 4 + (row >> 12)) * W + (t - (4096 - W))) * 2 + (part - 1)) * 1024 + hd;
                        *(f32x4*)kvp = v0; *(f32x4*)(kvp + 4) = v1; } } }
    }
};
}
constexpr int SC_XP = 0, SC_GB_P = 53888, SC_GB_S = 73728, SC_W = 107136, SC_WP = 208, SC_AGG = 147072, SC_CIN = 153216, SC_COLC = 153600, SC_PAIR = 156672;
__device__ __forceinline__ size_t xb_off(int nb2, int row) { return ((size_t)nb2 * MALL + row) * 96; }

__device__ __forceinline__ float sp8_of(float lam) { const float x = __builtin_amdgcn_exp2f(-LOG2E * lam);
    const float ser = x * (1.f + x * (-0.5f + x * (0.33333334f + x * (-0.25f + x * (0.2f + x * (-0.16666667f))))));
    const float l1p = (x < 0.125f) ? ser : LN2 * __log2f(1.f + x);
    return -8.f * LOG2E * l1p; }
__device__ __forceinline__ void scan_stage_colc(Frame& F, int j, int nb, int tid) {
    const int col0 = nb * 96;
    float cc8 = 0.f, cc8b = 0.f;
    { const int e = tid, row = e / 96, c = e - row * 96, gcol = j * 1536 + col0 + c;
      if (e < 480) cc8 = (row < 4) ? F.lru_conv_w()[((size_t)j * 4 + row) * 1536 + col0 + c] : F.lru_conv_b()[gcol];
      if (e < 288) { const int r2 = e / 96, c2 = e - r2 * 96, g2 = j * 1536 + col0 + c2;
          cc8b = (r2 == 0) ? F.lru_ba()[g2] : (r2 == 1) ? F.lru_bx()[g2] : sp8_of(F.lru_lambda()[g2]); } }
    if (tid < 480) ((LAS float*)(F.lds + SC_COLC))[tid] = cc8;
    if (tid < 288) ((LAS float*)(F.lds + SC_COLC))[480 + tid] = cc8b;
}

__device__ __forceinline__ void carry_publish(unsigned long long* g, float v) { __hip_atomic_store(g, (1ull << 32) | (unsigned long long)__builtin_bit_cast(unsigned, v), __ATOMIC_RELAXED, __HIP_MEMORY_SCOPE_AGENT); }
__device__ __forceinline__ float carry_wait(unsigned long long* g) { unsigned long long x; unsigned spins = 0;
    for (;;) { x = __hip_atomic_load(g, __ATOMIC_RELAXED, __HIP_MEMORY_SCOPE_AGENT); if ((unsigned)(x >> 32) == 1u || ++spins > (1u << 22)) break; __builtin_amdgcn_s_sleep(1); }
    return __builtin_bit_cast(float, (unsigned)x); }
__device__ __forceinline__ void scan_xp_dma(Frame& F, int nb, int pm, int w, int lane) {
    const bf16* xt = F.XG() + xb_off(nb, pm * 256) - 288;
#pragma unroll
    for (int i = 0; i < 7; ++i) { const int p = w * 7 + i; if (p < 49) glds16(xt + (size_t)(p * 64 + lane) * 8, (unsigned)(size_t)(F.lds + SC_XP + p * 1024)); }
}
__device__ __forceinline__ void scan_core(Frame& F, int j, int pm, int nb, int tid_in, bool samp, int sb0, int next_pm) {
    LAS unsigned char* lds = F.lds;
    int tid_ = tid_in; asm volatile("" : "+v"(tid_));
    const int tid = tid_, lane = tid & 63, w = __builtin_amdgcn_readfirstlane(tid >> 6), fr = lane & 15, fq = lane >> 4;
    constexpr int SC_GB = SC_GB_P, GBP = 192, XPI = 192;
    const int col0 = nb * 96, b = pm >> 4, ci = pm & 15;
    const bool active = !samp || w < 4;
    {
        if (!samp) { if (ci == 15 && tid < 288) { const int q = tid / 96, c = tid - q * 96;
            F.out()[OFF_PCONV + ((size_t)(j * 4 + b) * 3 + q) * 1536 + col0 + c] = bf2f(*(const LAS bf16*)(lds + SC_XP + (256 + q) * XPI + c * 2)); } }
        else { for (int e = tid; e < 16 * 288; e += 512) { const int lb = e / 288, rem = e - lb * 288, q = rem / 96, c = rem - q * 96;
            F.out()[OFF_SCONV + ((size_t)(j * 32 + sb0 + lb) * 3 + q) * 1536 + col0 + c] = bf2f(*(const LAS bf16*)(lds + SC_XP + (lb * 11 + 8 + q) * XPI + c * 2)); } }
    }
    if (active) {
    const LAS float* colc = (const LAS float*)(lds + SC_COLC);
    bf16x8 Af[2][3];
#pragma unroll
    for (int ks = 0; ks < 3; ++ks) {
        const int c8 = 32 * ks + 8 * fq;
        f32x4 cw[4][2], cb[2];
#pragma unroll
        for (int t = 0; t < 4; ++t) { cw[t][0] = *(const LAS f32x4*)(colc + t * 96 + c8); cw[t][1] = *(const LAS f32x4*)(colc + t * 96 + c8 + 4); }
        cb[0] = *(const LAS f32x4*)(colc + 4 * 96 + c8); cb[1] = *(const LAS f32x4*)(colc + 4 * 96 + c8 + 4);
#pragma unroll
        for (int m = 0; m < 2; ++m) { const int row = 32 * w + 16 * m + fr; const int rb = samp ? (row >> 3) * 11 + (row & 7) : row;
            f32x4 a0 = cb[0], a1 = cb[1];
#pragma unroll
            for (int t = 0; t < 4; ++t) { const v4u xv = *(const LAS v4u*)(lds + SC_XP + (rb + t) * XPI + c8 * 2);
                a0.x += cw[t][0].x * bflo(xv.x); a0.y += cw[t][0].y * bfhi(xv.x); a0.z += cw[t][0].z * bflo(xv.y); a0.w += cw[t][0].w * bfhi(xv.y);
                a1.x += cw[t][1].x * bflo(xv.z); a1.y += cw[t][1].y * bfhi(xv.z); a1.z += cw[t][1].z * bflo(xv.w); a1.w += cw[t][1].w * bfhi(xv.w); }
            v4u pk; pk.x = pk2(a0.x, a0.y); pk.y = pk2(a0.z, a0.w); pk.z = pk2(a1.x, a1.y); pk.w = pk2(a1.z, a1.w);
            Af[m][ks] = __builtin_bit_cast(bf16x8, pk); }
    }
    bf16x8 sel0, sel1;
    { const int e0 = (fq == 0 && fr < 8) ? fr : (fq == 1 && fr >= 8) ? fr - 8 : -1, e1 = (fq == 2 && fr < 8) ? fr : (fq == 3 && fr >= 8) ? fr - 8 : -1;
#pragma unroll
      for (int e = 0; e < 8; ++e) { sel0[e] = (e == e0) ? (short)0x3F80 : (short)0; sel1[e] = (e == e1) ? (short)0x3F80 : (short)0; } }
    LAS f32x2* aggL = (LAS f32x2*)(lds + SC_AGG);
#pragma unroll
    for (int half = 0; half < 2; ++half) {
    f32x4 av[2][3], uv[2][3]; float Pq[2][3], Hq[2][3];
#pragma unroll
    for (int n3 = 0; n3 < 3; ++n3) {
        const int nt = 3 * half + n3;
        const int col = 16 * nt + fr;
        bf16x8 Ba[3], Bx[3];
#pragma unroll
        for (int ks = 0; ks < 3; ++ks) {
            Ba[ks] = *(const LAS bf16x8*)(lds + SC_W + col * SC_WP + 64 * ks + 16 * fq); Bx[ks] = *(const LAS bf16x8*)(lds + SC_W + (96 + col) * SC_WP + 64 * ks + 16 * fq); }
        const float ba = colc[480 + col], bx = colc[576 + col], sp8 = colc[672 + col];
        float P4[2], H4[2];
#pragma unroll
        for (int m = 0; m < 2; ++m) {
            f32x4 rp = (f32x4){0.f, 0.f, 0.f, 0.f}, ip = rp, xc = rp;
#pragma unroll
            for (int ks = 0; ks < 3; ++ks) { rp = __builtin_amdgcn_mfma_f32_16x16x32_bf16(Af[m][ks], Ba[ks], rp, 0, 0, 0); ip = __builtin_amdgcn_mfma_f32_16x16x32_bf16(Af[m][ks], Bx[ks], ip, 0, 0, 0); }
            xc = __builtin_amdgcn_mfma_f32_16x16x32_bf16(Af[m][nt >> 1], (nt & 1) ? sel1 : sel0, xc, 0, 0, 0);
            f32x4 a4, u4;
#pragma unroll
            for (int e = 0; e < 4; ++e) { const float rr = sigmoid_f(rp[e] + ba), ig = sigmoid_f(ip[e] + bx), la = sp8 * rr;
                const float a = __builtin_amdgcn_exp2f(la); a4[e] = a; u4[e] = __builtin_amdgcn_sqrtf(fmaxf(1.f - a * a, 0.f)) * ig * xc[e]; }
            av[m][n3] = a4; uv[m][n3] = u4;
            P4[m] = (a4[0] * a4[1]) * (a4[2] * a4[3]);
            H4[m] = ((u4[0] * a4[1] + u4[1]) * a4[2] + u4[2]) * a4[3] + u4[3];
        }
        if (!samp) {
            float Pt[2], Ht[2];
#pragma unroll
            for (int m = 0; m < 2; ++m) {
                float P = P4[m], H = H4[m];
                { const float Pn = shup(P, lane, 16), Hn = shup(H, lane, 16); if (fq >= 1) { H = P * Hn + H; P = P * Pn; } }
                { const float Pn = shup(P, lane, 32), Hn = shup(H, lane, 32); if (fq >= 2) { H = P * Hn + H; P = P * Pn; } }
                const float Pe = shup(P, lane, 16), He = shup(H, lane, 16);
                Pq[m][n3] = (fq == 0) ? 1.f : Pe; Hq[m][n3] = (fq == 0) ? 0.f : He;
                Pt[m] = shl(P, 48 + fr); Ht[m] = shl(H, 48 + fr);
            }
            Hq[1][n3] = Pq[1][n3] * Ht[0] + Hq[1][n3]; Pq[1][n3] = Pq[1][n3] * Pt[0];
            if (fq == 0) { f32x2 t; t.x = Pt[0] * Pt[1]; t.y = Pt[1] * Ht[0] + Ht[1]; aggL[w * 96 + col] = t; }
        } else {
#pragma unroll
            for (int m = 0; m < 2; ++m) { const float Pn = shup(P4[m], lane, 16), Hn = shup(H4[m], lane, 16);
                Pq[m][n3] = (fq & 1) ? Pn : 1.f; Hq[m][n3] = (fq & 1) ? Hn : 0.f; }
        }
    }
    if (!samp) {
        if (half == 0) asm volatile("s_waitcnt vmcnt(0)" ::: "memory");
        __syncthreads();
        if (half == 0 && next_pm >= 0) scan_xp_dma(F, nb, next_pm, w, lane);
        unsigned long long* ag = F.carry() + (((size_t)(j * 64 + pm)) * 1536 + col0 + 48 * half) * 2;
        float Pu = 1.f, Hu = 0.f;
        if (tid < 48) {
#pragma unroll
            for (int ww = 0; ww < 8; ++ww) { const f32x2 t = aggL[ww * 96 + 48 * half + tid]; Hu = t.x * Hu + t.y; Pu = t.x * Pu; }
            carry_publish(ag + 2 * tid, Pu); carry_publish(ag + 2 * tid + 1, Hu); }
        if (tid < 384) { const int c = tid % 48, grp = tid / 48, c0 = 2 * grp; float P = 1.f, H = 0.f;
            unsigned long long* pg = F.carry() + (((size_t)(j * 64 + pm - ci + c0)) * 1536 + col0 + 48 * half + c) * 2;
            if (c0 < ci) {
                const bool two = c0 + 1 < ci; unsigned long long x0, x1, x2, x3; unsigned spins = 0;
                for (;;) { x0 = __hip_atomic_load(pg, __ATOMIC_RELAXED, __HIP_MEMORY_SCOPE_AGENT); x1 = __hip_atomic_load(pg + 1, __ATOMIC_RELAXED, __HIP_MEMORY_SCOPE_AGENT);
                    x2 = two ? __hip_atomic_load(pg + 3072, __ATOMIC_RELAXED, __HIP_MEMORY_SCOPE_AGENT) : (1ull << 32); x3 = two ? __hip_atomic_load(pg + 3073, __ATOMIC_RELAXED, __HIP_MEMORY_SCOPE_AGENT) : (1ull << 32);
                    if ((((unsigned)(x0 >> 32) & (unsigned)(x1 >> 32) & (unsigned)(x2 >> 32) & (unsigned)(x3 >> 32)) == 1u) || ++spins > (1u << 22)) break; __builtin_amdgcn_s_sleep(1); }
                P = __builtin_bit_cast(float, (unsigned)x0); H = __builtin_bit_cast(float, (unsigned)x1);
                if (two) { const float p1 = __builtin_bit_cast(float, (unsigned)x2), h1 = __builtin_bit_cast(float, (unsigned)x3); H = p1 * H + h1; P = p1 * P; } }
            f32x2 t; t.x = P; t.y = H; ((LAS f32x2*)(lds + SC_PAIR))[grp * 48 + c] = t; }
        __syncthreads();
        if (tid < 48) { float c = 0.f;
#pragma unroll
            for (int grp = 0; grp < 8; ++grp) { const f32x2 t = ((const LAS f32x2*)(lds + SC_PAIR))[grp * 48 + tid]; c = t.x * c + t.y; }
            ((LAS float*)(lds + SC_CIN))[48 * half + tid] = c;
            if (ci == 15) F.out()[OFF_PH + ((size_t)j * 4 + b) * 1536 + col0 + 48 * half + tid] = Pu * c + Hu; }
        __syncthreads();
    }
    {
#pragma unroll
        for (int n3 = 0; n3 < 3; ++n3) {
            const int nt = 3 * half + n3;
            const int col = 16 * nt + fr;
            float cwv = 0.f;
            if (!samp) { cwv = ((const LAS float*)(lds + SC_CIN))[col];
#pragma unroll
                for (int ww = 0; ww < 7; ++ww) if (ww < w) { const f32x2 t = aggL[ww * 96 + col]; cwv = t.x * cwv + t.y; } }
#pragma unroll
            for (int m = 0; m < 2; ++m) {
                const int sb = sb0 + 4 * w + 2 * m + (fq >> 1);
                float c = cwv; if (samp) c = F.state_h()[((size_t)j * 32 + sb) * 1536 + col0 + col];
                float h = Pq[m][n3] * c + Hq[m][n3];
#pragma unroll
                for (int e = 0; e < 4; ++e) { h = av[m][n3][e] * h + uv[m][n3][e];
                    const int row = 32 * w + 16 * m + 4 * fq + e;
                    const float gbv = bf2f(*(const LAS bf16*)(lds + SC_GB + row * GBP + col * 2));
                    *(LAS bf16*)(lds + SC_GB + row * GBP + col * 2) = (bf16)f2bf(h * silu_f(gbv)); }
                if (samp && (fq & 1)) F.out()[OFF_SH + ((size_t)j * 32 + sb) * 1536 + col0 + col] = h;
            }
        }
    }
    }
    }
    {
        __syncthreads();
        const int nch = samp ? 1536 : 3072; const size_t yrow0 = samp ? (size_t)MP + 8 * sb0 : (size_t)pm * 256;
#pragma unroll
        for (int i = 0; i < 6; ++i) { const int ch = tid + 512 * i, r = ch / 12, cc = ch - r * 12;
            if (ch < nch) *(GAS v4u*)(F.Y() + (yrow0 + r) * 1536 + col0 + cc * 8) = *(const LAS v4u*)(lds + SC_GB + r * GBP + cc * 16); }
    }
}

__device__ __forceinline__ void scan_phase(Frame& F, int j) {
    LAS unsigned char* lds = F.lds;
    int tid_ = F.tid; asm volatile("" : "+v"(tid_));
    const int tid = tid_, lane = tid & 63, w = __builtin_amdgcn_readfirstlane(tid >> 6), fr = lane & 15, fq = lane >> 4;
    const bf16* XB = F.XG();
    int o = F.vcu, nb_staged = -1;
#define SCAN_PM(O) ((((O) >> 4) & 3) * 16 + ((O) >> 6))
    __syncthreads();
    if (o < 1024) scan_xp_dma(F, o & 15, SCAN_PM(o), w, lane);
    for (; o < 1056; o += F.G) {
        const bool samp = o >= 1024; const int nb = o & 15, pm = samp ? 64 : SCAN_PM(o), sb0 = samp ? ((o >> 4) & 1) * 16 : 0;
        if (nb != nb_staged) {
            __syncthreads();
            scan_stage_colc(F, j, nb, tid);
            v4u wr5[5];
#pragma unroll
            for (int i = 0; i < 5; ++i) { const int ch = tid + 512 * i; if (ch < 2304) { const int r = ch / 12, cc = ch - r * 12;
                const bf16* src = (r < 96 ? F.wa_t() : F.wx_t()) + ((size_t)(j * 16 + nb) * 96 + (r < 96 ? r : r - 96)) * 96 + cc * 8; wr5[i] = *(const GAS v4u*)src; } }
#pragma unroll
            for (int i = 0; i < 5; ++i) { const int ch = tid + 512 * i; if (ch < 2304) { const int r = ch / 12, cc = ch - r * 12; *(LAS v4u*)(lds + SC_W + r * SC_WP + cc * 16) = wr5[i]; } }
            nb_staged = nb;
        }
        if (!samp) {
            asm volatile("s_waitcnt vmcnt(0)" ::: "memory");
            if ((pm & 15) == 0 && tid < 36) { v4u z4 = (v4u){0u, 0u, 0u, 0u}; asm volatile("" : "+v"(z4)); *(LAS v4u*)(lds + SC_XP + tid * 16) = z4; }
        } else {
#pragma unroll 1
            for (int i = 0; i < 5; ++i) { const int ch = tid + 512 * i; if (ch < 16 * 11 * 12) { const int lr = ch / 12, cc = ch - lr * 12, lb = lr / 11, q = lr - lb * 11, sb = sb0 + lb;
                v4u val;
                if (q < 3) { const float* sp = F.state_conv() + ((size_t)((j * 32 + sb) * 3 + q)) * 1536 + nb * 96 + cc * 8; const f32x4 a = *(const f32x4*)sp, c = *(const f32x4*)(sp + 4);
                    val.x = pk2(a.x, a.y); val.y = pk2(a.z, a.w); val.z = pk2(c.x, c.y); val.w = pk2(c.z, c.w); }
                else val = *(const GAS v4u*)(XB + xb_off(nb, MP + sb * 8 + q - 3) + cc * 8);
                *(LAS v4u*)(lds + SC_XP + lr * 192 + cc * 16) = val; } }
        }
        __syncthreads();
        { const bf16* gt = XB + xb_off(16 + nb, samp ? MP + 8 * sb0 : pm * 256);
          const int npw = samp ? 3 : 6;
#pragma unroll
          for (int i = 0; i < 6; ++i) if (i < npw) glds16(gt + (size_t)((w * npw + i) * 64 + lane) * 8, (unsigned)(size_t)(lds + SC_GB_P + (w * npw + i) * 1024)); }
        if (samp) { asm volatile("s_waitcnt vmcnt(0)" ::: "memory"); __syncthreads(); }
        const int on = o + F.G;
        scan_core(F, j, pm, nb, tid, samp, sb0, (on < 1024 && (on & 15) == nb) ? SCAN_PM(on) : -1);
        if (on < 1024 && (on & 15) != nb) { __syncthreads(); scan_xp_dma(F, on & 15, SCAN_PM(on), w, lane); }
    }
#undef SCAN_PM
}

__device__ __forceinline__ s16x4 vtr(const LAS unsigned char* p) { typedef short v4i16_t __attribute__((ext_vector_type(4)));
    return __builtin_bit_cast(s16x4, __builtin_amdgcn_ds_read_tr16_b64_v4i16((LAS v4i16_t*)p)); }

constexpr int ATT_SLOT = 65536;
struct AttnPre { bf16x8 q0, q1; v2u po[4]; float plse; v2u gt[4]; };

__device__ __forceinline__ size_t qb_off(int gp, int b, int h, int pp) { return (size_t)gp * 16777216u + ((size_t)((b * 16 + h) * 4096 + pp)) * 64; }
__device__ __forceinline__ void attn_issue(Frame& F, int G, int u, int slot, AttnPre& P, int tid, int w, int fr, int fq) {
    const int ld = 2 * G, DIL = 1 << ld, NCH = 32 >> ld, L = 4096 >> ld;
    const int b = u >> 9, h = (u >> 5) & 15, q32 = u & 31, c = q32 & (NCH - 1), r = q32 >> (5 - ld);
    const int lane = tid & 63;
    const bf16* kt = F.XG() + qb_off(3 * G + 1, b, h, r * L + 128 * c - 128);
#pragma unroll
    for (int i = 0; i < 4; ++i) {
        const int row = w * 32 + i * 8 + (lane >> 3), s = lane & 7, ch = s ^ (row & 7);
        const bf16* kp = kt + row * 64 + ch * 8;
        const unsigned dst = (unsigned)(size_t)(F.lds + slot * ATT_SLOT + (w * 32 + i * 8) * 128);
        glds16(kp, dst); glds16(kp + 16777216, dst + 32768u);
    }
    const int pq = r * L + 128 * c + 16 * w + fr;
    const bf16* qp = F.XG() + qb_off(3 * G, b, h, pq) + 8 * fq;
    P.q0 = *(const bf16x8*)qp; P.q1 = *(const bf16x8*)(qp + 32);
    const int tq = (128 * c + 16 * w + fr) * DIL + r;
    if (G > 0) { const bf16* op = (const bf16*)F.OACC() + ((size_t)((b * 16 + h) * 4096 + tq)) * 64 + 4 * fq;
#pragma unroll
        for (int nt = 0; nt < 4; ++nt) P.po[nt] = *(const GAS v2u*)(op + 16 * nt);
        P.plse = F.lse()[(size_t)(b * 16 + h) * 4096 + tq]; }
    if (G == 2) { const bf16* gp = F.XG() + qb_off(9, b, h, pq) + 4 * fq;
#pragma unroll
        for (int nt = 0; nt < 4; ++nt) P.gt[nt] = *(const GAS v2u*)(gp + 16 * nt); }
}
__device__ __forceinline__ void attn_pin(AttnPre& P) {
    asm volatile("" : "+v"(P.q0), "+v"(P.q1));
#pragma unroll
    for (int nt = 0; nt < 4; ++nt) asm volatile("" : "+v"(P.po[nt]), "+v"(P.gt[nt]));
    asm volatile("" : "+v"(P.plse));
}

__device__ __forceinline__ void attn_compute(Frame& F, int G, int u, int slot, const AttnPre& P, int w, int fr_, int fq_) {
    const int ld = 2 * G, DIL = 1 << ld, NCH = 32 >> ld;
    int fr = fr_, fq = fq_; asm volatile("" : "+v"(fr), "+v"(fq));
    const int lane = fr + 16 * fq;
    const int b = u >> 9, h = (u >> 5) & 15, q32 = u & 31, c = q32 & (NCH - 1), r = q32 >> (5 - ld);
    const LAS unsigned char* kb = F.lds + slot * ATT_SLOT + (16 * w + fr) * 128;
    const LAS unsigned char* kb0 = kb + ((fq ^ (fr & 7)) << 4); const LAS unsigned char* kb1 = kb + (((4 + fq) ^ (fr & 7)) << 4);
    f32x4 st[9];
    { bf16x8 kf[9][2];
#pragma unroll
      for (int T = 0; T < 9; ++T) { kf[T][0] = *(const LAS bf16x8*)(kb0 + T * 2048); kf[T][1] = *(const LAS bf16x8*)(kb1 + T * 2048); }
#pragma unroll
      for (int T = 0; T < 9; ++T) { f32x4 s = (f32x4){0.f, 0.f, 0.f, 0.f};
        s = __builtin_amdgcn_mfma_f32_16x16x32_bf16(kf[T][0], P.q0, s, 0, 0, 0); s = __builtin_amdgcn_mfma_f32_16x16x32_bf16(kf[T][1], P.q1, s, 0, 0, 0); st[T] = s; } }
    const float slope = __builtin_amdgcn_exp2f(-0.5f * (float)(h + 1));
    const float c1 = 0.125f * LOG2E, c2 = slope * (float)DIL * LOG2E;
    const float d0 = (float)(fr - 4 * fq + 128) * c2;
    float mx = -1e30f;
#pragma unroll
    for (int T = 0; T < 9; ++T)
#pragma unroll
        for (int e = 0; e < 4; ++e) { float s2 = st[T][e] * c1 - (d0 - c2 * (float)(16 * T + e));
            if (T == 0) s2 = (4 * fq + e >= fr) ? s2 : -1e30f;
            if (T == 8) s2 = (4 * fq + e <= fr) ? s2 : -1e30f;
            st[T][e] = s2; }
    if (c == 0) {
        const int thr = 128 - 16 * w - 4 * fq;
#pragma unroll
        for (int T = 0; T < 9; ++T)
#pragma unroll
            for (int e = 0; e < 4; ++e) st[T][e] = (16 * T + e >= thr) ? st[T][e] : -1e30f;
    }
#pragma unroll
    for (int T = 0; T < 9; ++T) mx = fmaxf(mx, fmaxf(fmaxf(st[T][0], st[T][1]), fmaxf(st[T][2], st[T][3])));
    mx = fmaxf(mx, shx(mx, lane, 16)); mx = fmaxf(mx, shx(mx, lane, 32));
    float ls = 0.f;
#pragma unroll
    for (int T = 0; T < 9; ++T)
#pragma unroll
        for (int e = 0; e < 4; ++e) { const float p = __builtin_amdgcn_exp2f(st[T][e] - mx); ls += p; st[T][e] = p; }
    ls += shx(ls, lane, 16); ls += shx(ls, lane, 32);
    f32x4 o[4];
#pragma unroll
    for (int nt = 0; nt < 4; ++nt) o[nt] = (f32x4){0.f, 0.f, 0.f, 0.f};
    const int sw = 4 * (fq & 1) + (fr >> 2);
    const LAS unsigned char* vrow = F.lds + slot * ATT_SLOT + 32768 + (16 * w + 4 * fq + (fr >> 2)) * 128 + (fr & 1) * 8;
    const LAS unsigned char* vbs[4];
#pragma unroll
    for (int nt = 0; nt < 4; ++nt) vbs[nt] = vrow + (((2 * nt + ((fr >> 1) & 1)) ^ sw) << 4);
    s16x4 vl[5][4], vh[4][4];
#pragma unroll
    for (int kk = 0; kk < 5; ++kk)
#pragma unroll
        for (int nt = 0; nt < 4; ++nt) { vl[kk][nt] = vtr(vbs[nt] + kk * 4096); if (kk < 4) vh[kk][nt] = vtr(vbs[nt] + kk * 4096 + 2048); }
#pragma unroll
    for (int kk = 0; kk < 5; ++kk) {
        v4u pk; pk.x = pk2(st[2 * kk][0], st[2 * kk][1]); pk.y = pk2(st[2 * kk][2], st[2 * kk][3]);
        if (kk < 4) { const int t1 = (2 * kk + 1 < 9) ? 2 * kk + 1 : 8; pk.z = pk2(st[t1][0], st[t1][1]); pk.w = pk2(st[t1][2], st[t1][3]); } else { pk.z = 0u; pk.w = 0u; }
        const bf16x8 pf = __builtin_bit_cast(bf16x8, pk);
#pragma unroll
        for (int nt = 0; nt < 4; ++nt) {
            const s16x4 lo = vl[kk][nt], hi = (kk < 4) ? vh[kk < 4 ? kk : 3][nt] : lo;
            bf16x8 vf; vf[0] = lo[0]; vf[1] = lo[1]; vf[2] = lo[2]; vf[3] = lo[3]; vf[4] = hi[0]; vf[5] = hi[1]; vf[6] = hi[2]; vf[7] = hi[3];
            o[nt] = __builtin_amdgcn_mfma_f32_16x16x32_bf16(vf, pf, o[nt], 0, 0, 0); }
    }
    const float inv = __builtin_amdgcn_rcpf(ls);
#pragma unroll
    for (int nt = 0; nt < 4; ++nt) o[nt] = o[nt] * inv;
    float lse = (mx + __log2f(ls)) * LN2;
    const int tq = (128 * c + 16 * w + fr) * DIL + r; const size_t row = (size_t)b * SEQ + tq;
    if (G > 0) { const float lp = P.plse; const float m2 = fmaxf(lp, lse); const float ln = m2 + __logf(__expf(lp - m2) + __expf(lse - m2));
        const float wp = __expf(lp - ln), wc = __expf(lse - ln);
#pragma unroll
        for (int nt = 0; nt < 4; ++nt) { const v2u pv = P.po[nt]; const f32x4 po = (f32x4){bflo(pv.x), bfhi(pv.x), bflo(pv.y), bfhi(pv.y)}; o[nt] = po * wp + o[nt] * wc; }
        lse = ln; }
    if (G == 2) {
#pragma unroll
        for (int nt = 0; nt < 4; ++nt) { const v2u gw = P.gt[nt];
            v2u y; y.x = pk2(o[nt].x * silu_f(bflo(gw.x)), o[nt].y * silu_f(bfhi(gw.x))); y.y = pk2(o[nt].z * silu_f(bflo(gw.y)), o[nt].w * silu_f(bfhi(gw.y)));
            *(GAS v2u*)(F.Y() + row * 1024 + h * 64 + 16 * nt + 4 * fq) = y; }
    } else { bf16* op = (bf16*)F.OACC() + ((size_t)((b * 16 + h) * 4096 + tq)) * 64 + 4 * fq;
#pragma unroll
        for (int nt = 0; nt < 4; ++nt) { v2u pv; pv.x = pk2(o[nt].x, o[nt].y); pv.y = pk2(o[nt].z, o[nt].w); *(GAS v2u*)(op + 16 * nt) = pv; }
        if (fq == 0) F.lse()[(size_t)(b * 16 + h) * 4096 + tq] = lse; }
}

struct BlkList { int sub, ns, sp0, sps, glo, ghi; };
__device__ __forceinline__ int blk_count(const BlkList& L) { return L.sub == 0 ? (L.ghi - L.glo) * L.ns * 4 : L.ns * 8; }
__device__ __forceinline__ void blk_at(const BlkList& L, int i, int& G, int& u) {
    if (L.sub != 0) { const int sp = L.sp0 + (i >> 3) * L.sps; G = 2; u = sp * 8 + (i & 7); return; }
    const int per = L.ns * 4, gi = i / per, r = i - gi * per, sp = L.sp0 + (r >> 2) * L.sps, k = r & 3, bh = sp >> 3, c5 = sp & 7;
    G = L.glo + gi; u = (G == 0) ? bh * 32 + 4 * c5 + k : bh * 32 + c5 + 8 * k;
}
__device__ __forceinline__ void attn_blocks(Frame& F, const BlkList& L) {
    int tid_ = F.tid; asm volatile("" : "+v"(tid_));
    const int tid = tid_, lane = tid & 63, w = __builtin_amdgcn_readfirstlane(tid >> 6), fr = lane & 15, fq = lane >> 4;
    const int n = blk_count(L);
    if (n <= 0) return;
    asm volatile("s_waitcnt vmcnt(0)" ::: "memory");
    __syncthreads();
    AttnPre Pc, Pn;
#pragma unroll
    for (int nt = 0; nt < 4; ++nt) { Pc.po[nt] = (v2u){0u, 0u}; Pc.gt[nt] = (v2u){0u, 0u}; } Pc.plse = 0.f; Pn = Pc;
    int Gc, uc; blk_at(L, 0, Gc, uc);
    attn_issue(F, Gc, uc, 0, Pc, tid, w, fr, fq);
    asm volatile("s_waitcnt vmcnt(0)" ::: "memory"); attn_pin(Pc);
    asm volatile("s_waitcnt lgkmcnt(0)\n\ts_barrier" ::: "memory");
    for (int i = 0; i < n; ++i) {
        const int slot = i & 1;
        int Gn, un; blk_at(L, (i + 1 < n) ? i + 1 : i, Gn, un);
        attn_issue(F, Gn, un, slot ^ 1, Pn, tid, w, fr, fq);
        attn_compute(F, Gc, uc, slot, Pc, w, fr, fq);
        asm volatile("s_waitcnt vmcnt(4)" ::: "memory"); attn_pin(Pn);
        asm volatile("s_waitcnt lgkmcnt(0)\n\ts_barrier" ::: "memory");
        Pc = Pn; Gc = Gn; uc = un;
    }
}

__device__ __forceinline__ void up16(const v4u& a, const v4u& c, float (&x)[16]) {
    x[0] = bflo(a.x); x[1] = bfhi(a.x); x[2] = bflo(a.y); x[3] = bfhi(a.y); x[4] = bflo(a.z); x[5] = bfhi(a.z); x[6] = bflo(a.w); x[7] = bfhi(a.w);
    x[8] = bflo(c.x); x[9] = bfhi(c.x); x[10] = bflo(c.y); x[11] = bfhi(c.y); x[12] = bflo(c.z); x[13] = bfhi(c.z); x[14] = bflo(c.w); x[15] = bfhi(c.w); }
__device__ __forceinline__ void attn_sample_task(Frame& F, int G, int j, int sb, int t, int pair, int hf) {
    const int ld = 2 * G, DIL = 1 << ld, BUF = 128 << ld;
    LAS unsigned char* lds = F.lds;
    int tid_ = F.tid; asm volatile("" : "+v"(tid_));
    const int lane = tid_ & 63, w = __builtin_amdgcn_readfirstlane(tid_ >> 6), h = lane >> 2;
    const float* cache = F.A->in[4 + G];
    const float* cbase = cache + (size_t)(j * 32 + sb) * BUF * 2048 + 16 * lane;
    const bf16* qs = F.QS() + G * 3072 + 16 * lane;
    const int t2 = t + DIL;
    float qa[16], qb[16];
    { const bf16* p = qs + ((size_t)sb * 8 + t) * NQKVG; const v4u a = *(const GAS v4u*)p, c = *(const GAS v4u*)(p + 8); up16(a, c, qa); }
    { const bf16* p = qs + ((size_t)sb * 8 + (pair ? t2 : t)) * NQKVG; const v4u a = *(const GAS v4u*)p, c = *(const GAS v4u*)(p + 8); up16(a, c, qb); }
    const float slope = __builtin_amdgcn_exp2f(-0.5f * (float)(h + 1));
    const float c1 = 0.125f * LOG2E, c2 = slope * (float)DIL * LOG2E;
    float ma = -1e30f, la = 0.f, oa[16], mb = -1e30f, lb = 0.f, ob[16];
#pragma unroll
    for (int e = 0; e < 16; ++e) { oa[e] = 0.f; ob[e] = 0.f; }
    const int nnew = t >> ld;
    { const int s = w - 1;
      if (hf == 0 && s <= nnew && (s >= 0 || pair)) { const bf16* kp = qs + ((size_t)sb * 8 + (t - DIL * s)) * NQKVG + 1024;
        const v4u a = *(const GAS v4u*)kp, c = *(const GAS v4u*)(kp + 8), d = *(const GAS v4u*)(kp + 1024), f = *(const GAS v4u*)(kp + 1032);
        float kx[16], vx[16]; up16(a, c, kx); up16(d, f, vx);
        float da = 0.f, db = 0.f;
#pragma unroll
        for (int e = 0; e < 16; ++e) { da += qa[e] * kx[e]; db += qb[e] * kx[e]; }
        da += shx(da, lane, 1); da += shx(da, lane, 2); db += shx(db, lane, 1); db += shx(db, lane, 2);
        if (s >= 0) { ma = da * c1 - c2 * (float)s; la = 1.f;
#pragma unroll
            for (int e = 0; e < 16; ++e) oa[e] = vx[e]; }
        if (pair) { mb = db * c1 - c2 * (float)(s + 1); lb = 1.f;
#pragma unroll
            for (int e = 0; e < 16; ++e) ob[e] = vx[e]; } } }
    const int slo = hf ? 65 : nnew + 1, shi = hf ? 128 : 64;
    for (int s0 = slo + w; s0 <= shi; s0 += 32) {
        f32x4 kk[4][4], vv[4][4];
#pragma unroll
        for (int i = 0; i < 4; ++i) { const int s = s0 + 8 * i, sc = s <= shi ? s : shi; const float* kp = cbase + (size_t)(BUF + t - DIL * sc) * 2048;
#pragma unroll
            for (int e4 = 0; e4 < 4; ++e4) { kk[i][e4] = *(const f32x4*)(kp + 4 * e4); vv[i][e4] = *(const f32x4*)(kp + 1024 + 4 * e4); } }
        float sa[4], sbv[4];
#pragma unroll
        for (int i = 0; i < 4; ++i) { float da = 0.f, db = 0.f;
#pragma unroll
            for (int e4 = 0; e4 < 4; ++e4) { da += qa[4 * e4] * kk[i][e4].x + qa[4 * e4 + 1] * kk[i][e4].y + qa[4 * e4 + 2] * kk[i][e4].z + qa[4 * e4 + 3] * kk[i][e4].w;
                                             db += qb[4 * e4] * kk[i][e4].x + qb[4 * e4 + 1] * kk[i][e4].y + qb[4 * e4 + 2] * kk[i][e4].z + qb[4 * e4 + 3] * kk[i][e4].w; }
            da += shx(da, lane, 1); da += shx(da, lane, 2); db += shx(db, lane, 1); db += shx(db, lane, 2);
            const int s = s0 + 8 * i; sa[i] = (s <= shi) ? da * c1 - c2 * (float)s : -1e30f; sbv[i] = (pair && s <= shi && s < 128) ? db * c1 - c2 * (float)(s + 1) : -1e30f; }
        { const float mn = fmaxf(fmaxf(ma, sa[0]), fmaxf(fmaxf(sa[1], sa[2]), sa[3])), al = __builtin_amdgcn_exp2f(ma - mn);
          float p[4];
#pragma unroll
          for (int i = 0; i < 4; ++i) p[i] = __builtin_amdgcn_exp2f(sa[i] - mn);
          la = la * al + (p[0] + p[1]) + (p[2] + p[3]); ma = mn;
#pragma unroll
          for (int e4 = 0; e4 < 4; ++e4) {
            oa[4 * e4] = oa[4 * e4] * al + (p[0] * vv[0][e4].x + p[1] * vv[1][e4].x) + (p[2] * vv[2][e4].x + p[3] * vv[3][e4].x);
            oa[4 * e4 + 1] = oa[4 * e4 + 1] * al + (p[0] * vv[0][e4].y + p[1] * vv[1][e4].y) + (p[2] * vv[2][e4].y + p[3] * vv[3][e4].y);
            oa[4 * e4 + 2] = oa[4 * e4 + 2] * al + (p[0] * vv[0][e4].z + p[1] * vv[1][e4].z) + (p[2] * vv[2][e4].z + p[3] * vv[3][e4].z);
            oa[4 * e4 + 3] = oa[4 * e4 + 3] * al + (p[0] * vv[0][e4].w + p[1] * vv[1][e4].w) + (p[2] * vv[2][e4].w + p[3] * vv[3][e4].w); } }
        if (pair) { const float mn = fmaxf(fmaxf(mb, sbv[0]), fmaxf(fmaxf(sbv[1], sbv[2]), sbv[3])), al = __builtin_amdgcn_exp2f(mb - mn);
          float p[4];
#pragma unroll
          for (int i = 0; i < 4; ++i) p[i] = __builtin_amdgcn_exp2f(sbv[i] - mn);
          lb = lb * al + (p[0] + p[1]) + (p[2] + p[3]); mb = mn;
#pragma unroll
          for (int e4 = 0; e4 < 4; ++e4) {
            ob[4 * e4] = ob[4 * e4] * al + (p[0] * vv[0][e4].x + p[1] * vv[1][e4].x) + (p[2] * vv[2][e4].x + p[3] * vv[3][e4].x);
            ob[4 * e4 + 1] = ob[4 * e4 + 1] * al + (p[0] * vv[0][e4].y + p[1] * vv[1][e4].y) + (p[2] * vv[2][e4].y + p[3] * vv[3][e4].y);
            ob[4 * e4 + 2] = ob[4 * e4 + 2] * al + (p[0] * vv[0][e4].z + p[1] * vv[1][e4].z) + (p[2] * vv[2][e4].z + p[3] * vv[3][e4].z);
            ob[4 * e4 + 3] = ob[4 * e4 + 3] * al + (p[0] * vv[0][e4].w + p[1] * vv[1][e4].w) + (p[2] * vv[2][e4].w + p[3] * vv[3][e4].w); } }
    }
    __syncthreads();
    LAS float* oL = (LAS float*)lds; LAS f32x2* mlL = (LAS f32x2*)(lds + 65536);
#pragma unroll
    for (int e4 = 0; e4 < 4; ++e4) { *(LAS f32x4*)(oL + w * 1024 + 16 * lane + 4 * e4) = (f32x4){oa[4 * e4], oa[4 * e4 + 1], oa[4 * e4 + 2], oa[4 * e4 + 3]};
                                     *(LAS f32x4*)(oL + 8192 + w * 1024 + 16 * lane + 4 * e4) = (f32x4){ob[4 * e4], ob[4 * e4 + 1], ob[4 * e4 + 2], ob[4 * e4 + 3]}; }
    { f32x2 x; x.x = ma; x.y = la; mlL[w * 64 + lane] = x; x.x = mb; x.y = lb; mlL[512 + w * 64 + lane] = x; }
    __syncthreads();
    if (w == 0 || (w == 1 && pair)) {
        const LAS float* oq = oL + w * 8192; const LAS f32x2* mq = mlL + w * 512; const int task = sb * 8 + (w ? t2 : t);
        float M = -1e30f;
#pragma unroll
        for (int ww = 0; ww < 8; ++ww) M = fmaxf(M, mq[ww * 64 + lane].x);
        float Lsum = 0.f; f32x4 acc[4];
#pragma unroll
        for (int e4 = 0; e4 < 4; ++e4) acc[e4] = (f32x4){0.f, 0.f, 0.f, 0.f};
#pragma unroll
        for (int ww = 0; ww < 8; ++ww) { const f32x2 x = mq[ww * 64 + lane]; const float sc = __builtin_amdgcn_exp2f(x.x - M); Lsum += x.y * sc;
#pragma unroll
            for (int e4 = 0; e4 < 4; ++e4) acc[e4] = acc[e4] + *(const LAS f32x4*)(oq + ww * 1024 + 16 * lane + 4 * e4) * sc; }
        const float inv = (Lsum > 0.f) ? 1.f / Lsum : 0.f; const float lse = (Lsum > 0.f) ? (M + __log2f(Lsum)) * LN2 : -1e30f;
        float* op = F.SO() + ((size_t)(G * 2 + hf) * 256 + task) * 1024 + 16 * lane;
#pragma unroll
        for (int e4 = 0; e4 < 4; ++e4) *(f32x4*)(op + 4 * e4) = acc[e4] * inv;
        if ((lane & 3) == 0) F.SLSE()[((size_t)(G * 2 + hf) * 256 + task) * 16 + h] = lse;
    }
}
__device__ __forceinline__ void attn_sample_combine(Frame& F, int task) {
    int tid_ = F.tid; asm volatile("" : "+v"(tid_));
    const int c = 2 * tid_, h = c >> 6; const size_t qrow = (size_t)MP + task;
    float l[6]; f32x2 a[6]; float mx = -1e30f;
#pragma unroll
    for (int p = 0; p < 6; ++p) { l[p] = F.SLSE()[((size_t)p * 256 + task) * 16 + h]; a[p] = *(const f32x2*)(F.SO() + ((size_t)p * 256 + task) * 1024 + c); }
    const unsigned gw = *(const GAS unsigned*)(F.QS() + (size_t)task * NQKVG + 9216 + c);
#pragma unroll
    for (int p = 0; p < 6; ++p) mx = fmaxf(mx, l[p]);
    float den = 0.f, o0 = 0.f, o1 = 0.f;
#pragma unroll
    for (int p = 0; p < 6; ++p) { const float e = __expf(l[p] - mx); den += e; o0 += a[p].x * e; o1 += a[p].y * e; }
    const float inv = 1.f / den;
    *(GAS unsigned*)(F.Y() + qrow * 1024 + c) = pk2(o0 * inv * silu_f(bflo(gw)), o1 * inv * silu_f(bfhi(gw)));
}

__device__ __forceinline__ void attn_phase(Frame& F, int sub, int j) {
    const int nunit = sub == 0 ? 512 : 256, ngg = sub == 0 ? 2 : 1;
    const bool tasks_first = false;
    for (int pass = 0; pass < 2; ++pass) {
        if ((pass == 0) == tasks_first) {
            if (sub == 0) {
                for (int x = F.vcu; x < 1024; x += F.G) { const int id = x & 511; int g, sb, t, pair, hf;
                    if (x < 512) { const int r = id >> 1, pr = (r >> 1) & 3; g = id & 1; hf = r & 1; sb = r >> 3; t = g ? pr : 2 * pr; pair = 1; }
                    else { const int task = id >> 1; g = 2; hf = id & 1; sb = task >> 3; t = task & 7; pair = 0; }
                    attn_sample_task(F, g, j, sb, t, pair, hf); } }
        } else {
            const int ns = (nunit - F.vcu + F.G - 1) / F.G;
            const int ncall = (sub == 0 && ns < 2) ? 2 : 1;
            for (int cl = 0; cl < ncall; ++cl) { BlkList L; L.sub = sub; L.ns = ns; L.sp0 = F.vcu; L.sps = F.G; L.glo = (ncall == 2) ? cl : 0; L.ghi = (ncall == 2) ? cl + 1 : 2; attn_blocks(F, L); }
        }
    }
    if (sub == 1) for (int task = F.vcu; task < 256; task += F.G) attn_sample_combine(F, task);
}
template <int NT, class Epi>
__device__ __forceinline__ void sgemm_unit(Frame& F, const bf16* A, const bf16* Bt, int K, int n0, const Epi& E) {
    int tid_ = F.tid; asm volatile("" : "+v"(tid_));
    const int lane = tid_ & 63, w = __builtin_amdgcn_readfirstlane(tid_ >> 6), fr = lane & 15, fq = lane >> 4;
    constexpr int STAGE = (256 + 16 * NT) * 128;
    static_assert(3 * STAGE <= RING_BYTES + 16384, "sgemm ring");
    f32x4 acc[2][NT];
#pragma unroll
    for (int m = 0; m < 2; ++m)
#pragma unroll
        for (int nt = 0; nt < NT; ++nt) acc[m][nt] = (f32x4){0.f, 0.f, 0.f, 0.f};
    const int nch = K >> 6;
    const int r8 = lane >> 3, s8 = lane & 7;
    const bf16* asrc[4];
#pragma unroll
    for (int i = 0; i < 4; ++i) { const int row = w * 32 + i * 8 + r8; asrc[i] = A + (size_t)row * K + ((s8 ^ (row & 7)) << 3); }
    const int bp = w % (2 * NT), brow = bp * 8 + r8;
    const bf16* bsrc = Bt + (size_t)(n0 + brow) * K + ((s8 ^ (brow & 7)) << 3);
#define SG_ISSUE(C, SLOT) do { const unsigned sb_ = (unsigned)(size_t)(F.lds + (SLOT) * STAGE); \
        _Pragma("unroll") for (int i = 0; i < 4; ++i) glds16(asrc[i] + (size_t)(C) * 64, sb_ + (unsigned)((w * 32 + i * 8) * 128)); \
        glds16(bsrc + (size_t)(C) * 64, sb_ + 32768u + (unsigned)(bp * 1024)); } while (0)
    __syncthreads();
    SG_ISSUE(0, 0); SG_ISSUE(1, 1);
    int slot = 0;
    for (int c = 0; c < nch; ++c) {
        if (c + 1 < nch) asm volatile("s_waitcnt vmcnt(5)" ::: "memory"); else asm volatile("s_waitcnt vmcnt(0)" ::: "memory");
        asm volatile("s_waitcnt lgkmcnt(0)\n\ts_barrier" ::: "memory");
        if (c + 2 < nch) { const int s2 = (slot + 2 >= 3) ? slot - 1 : slot + 2; SG_ISSUE(c + 2, s2); }
        const LAS unsigned char* sa = F.lds + slot * STAGE; const LAS unsigned char* sbp = sa + 32768;
        bf16x8 af[2][2], bq[NT][2];
#pragma unroll
        for (int m = 0; m < 2; ++m)
#pragma unroll
            for (int ks = 0; ks < 2; ++ks) { const int row = 32 * w + 16 * m + fr; af[m][ks] = *(const LAS bf16x8*)(sa + row * 128 + (((4 * ks + fq) ^ (row & 7)) << 4)); }
#pragma unroll
        for (int nt = 0; nt < NT; ++nt)
#pragma unroll
            for (int ks = 0; ks < 2; ++ks) { const int row = 16 * nt + fr; bq[nt][ks] = *(const LAS bf16x8*)(sbp + row * 128 + (((4 * ks + fq) ^ (row & 7)) << 4)); }
#pragma unroll
        for (int ks = 0; ks < 2; ++ks)
#pragma unroll
            for (int m = 0; m < 2; ++m)
#pragma unroll
                for (int nt = 0; nt < NT; ++nt) acc[m][nt] = __builtin_amdgcn_mfma_f32_16x16x32_bf16(bq[nt][ks], af[m][ks], acc[m][nt], 0, 0, 0);
        slot = (slot == 2) ? 0 : slot + 1;
    }
#undef SG_ISSUE
    typename Epi::Pre pre[2][NT];
#pragma unroll
    for (int m = 0; m < 2; ++m)
#pragma unroll
        for (int nt = 0; nt < NT; ++nt) pre[m][nt] = E.ld(32 * w + 16 * m + fr, n0 + 16 * nt + 4 * fq);
#pragma unroll
    for (int m = 0; m < 2; ++m)
#pragma unroll
        for (int nt = 0; nt < NT; ++nt) E.st(acc[m][nt], pre[m][nt], 32 * w + 16 * m + fr, n0 + 16 * nt + 4 * fq);
    if constexpr (Epi::HAS_FINISH) E.template finish<NT>(acc, w, fr, fq, n0);
}
struct SEpiXg { static constexpr bool HAS_FINISH = false; const Frame& F; int l; bool fused;
    struct Pre { f32x4 sw; float rss; };
    __device__ __forceinline__ Pre ld(int row, int col) const { Pre p; p.sw = (f32x4){0.f, 0.f, 0.f, 0.f}; p.rss = 1024.f;
        if (fused) { p.rss = F.RSS(l)[MP + row]; p.sw = *(const f32x4*)(F.SW(l) + (size_t)(4 + (row >> 3)) * 3072 + col); } return p; }
    __device__ __forceinline__ void st(const f32x4& a, const Pre& p, int row, int col) const { const int nb2 = col / 96, cin = col - nb2 * 96;
        f32x4 v = a; if (fused) v = a * __builtin_amdgcn_rsqf(p.rss * (1.f / 1024.f) + 1e-6f) + p.sw;
        v2u wv; wv.x = pk2(v.x, v.y); wv.y = pk2(v.z, v.w); *(GAS v2u*)(F.XG() + ((size_t)nb2 * MALL + MP + row) * 96 + cin) = wv; } };
struct SEpiResid { static constexpr bool HAS_FINISH = true; const Frame& F; int l; bool hasnext; bool fin;
    struct Pre { f32x4 x, g, gn, sc; };
    __device__ __forceinline__ Pre ld(int row, int col) const { Pre p; const int mr = 4 + (row >> 3);
        const float* xin = (l == 0) ? F.x_sample() : F.XL(l - 1) + (size_t)MP * 1024;
        p.x = *(const f32x4*)(xin + (size_t)row * 1024 + col); p.g = *(const f32x4*)(F.mod() + (size_t)l * 36 * 3072 + 2048 + (size_t)mr * 3072 + col);
        p.gn = p.g; p.sc = p.g;
        if (hasnext) { p.gn = *(const f32x4*)(F.norm_g() + (l + 1) * 1024 + col); p.sc = *(const f32x4*)(F.mod() + (size_t)(l + 1) * 36 * 3072 + 1024 + (size_t)mr * 3072 + col); } return p; }
    __device__ __forceinline__ void st(f32x4& v, const Pre& p, int row, int col) const {
        const f32x4 x = p.x + p.g * v;
        if (fin) { v = x; return; }
        *(f32x4*)(F.XL(l) + (size_t)(MP + row) * 1024 + col) = x;
        if (hasnext) { const f32x4 h = x * p.gn * (p.sc + 1.f);
            v2u wv; wv.x = pk2(h.x, h.y); wv.y = pk2(h.z, h.w); *(GAS v2u*)(F.HN() + (size_t)(MP + row) * 1024 + col) = wv;
            float s = (x.x * x.x + x.y * x.y) + (x.z * x.z + x.w * x.w); const int fq = (col >> 2) & 3, ln = (row & 15) + 16 * fq;
            s += __builtin_bit_cast(float, __builtin_amdgcn_ds_bpermute((ln ^ 16) << 2, __builtin_bit_cast(int, s))); s += __builtin_bit_cast(float, __builtin_amdgcn_ds_bpermute((ln ^ 32) << 2, __builtin_bit_cast(int, s)));
            if (fq == 0) atomicAdd(F.RSS(l + 1) + MP + row, s); } }
    template <int NT> __device__ __forceinline__ void finish(f32x4 (&acc)[2][NT], int w, int fr, int fq, int n0) const {
        if (!fin) return;
        float* rss = F.RSS(0) + MP; const int ln = fr + 16 * fq; float got = 0.f;
        float sm[2];
#pragma unroll
        for (int m = 0; m < 2; ++m) { float s = 0.f;
#pragma unroll
            for (int nt = 0; nt < NT; ++nt) { const f32x4 x = acc[m][nt]; s += (x.x * x.x + x.y * x.y) + (x.z * x.z + x.w * x.w); }
            s += __builtin_bit_cast(float, __builtin_amdgcn_ds_bpermute((ln ^ 16) << 2, __builtin_bit_cast(int, s))); s += __builtin_bit_cast(float, __builtin_amdgcn_ds_bpermute((ln ^ 32) << 2, __builtin_bit_cast(int, s)));
            sm[m] = s; }
        if (fq == 0) { float r0 = atomicAdd(rss + 32 * w + fr, sm[0]), r1 = atomicAdd(rss + 32 * w + 16 + fr, sm[1]); asm volatile("" : "+v"(r0), "+v"(r1)); got = r0; }
        asm volatile("s_waitcnt vmcnt(0)" : "+v"(got) :: "memory");
        gu32* cnt = F.ctl() + CW_FIN + 64 * FIN_STRIDE;
        if (ln == 0) __hip_atomic_fetch_add(cnt, 1u, RLX_AGENT);
        for (int it = 0; it < (1 << 20); ++it) { if (__hip_atomic_load(cnt, RLX_AGENT) >= 128u) break; __builtin_amdgcn_s_sleep(2); }
        float* out = F.out() + OFF_YS; const float* fg = F.final_g();
#pragma unroll
        for (int m = 0; m < 2; ++m) { const int row = 32 * w + 16 * m + fr; const float rs = __builtin_amdgcn_rsqf(__hip_atomic_load(rss + row, RLX_AGENT) * (1.f / 1024.f) + 1e-6f);
#pragma unroll
            for (int nt = 0; nt < NT; ++nt) { const int col = n0 + 16 * nt + 4 * fq; *(f32x4*)(out + (size_t)row * 1024 + col) = acc[m][nt] * rs * *(const f32x4*)(fg + col); } }
    } };
struct SEpiQkv { static constexpr bool HAS_FINISH = false; const Frame& F; int l; int j;
    struct Pre { f32x4 sw; float rss; };
    __device__ __forceinline__ Pre ld(int row, int col) const { Pre p; p.rss = F.RSS(l)[MP + row]; p.sw = *(const f32x4*)(F.SW(l) + (size_t)(4 + (row >> 3)) * 10240 + col); return p; }
    __device__ __forceinline__ void st(const f32x4& a, const Pre& p, int row, int col) const {
        const f32x4 v = a * __builtin_amdgcn_rsqf(p.rss * (1.f / 1024.f) + 1e-6f) + p.sw;
        v2u wv; wv.x = pk2(v.x, v.y); wv.y = pk2(v.z, v.w); *(GAS v2u*)(F.QS() + (size_t)row * NQKVG + col) = wv;
        const int g = col / 3072, part = (col % 3072) / 1024;
        if (g < 3 && part >= 1) { const size_t offs = (g == 0) ? OFF_SKV0 : (g == 1) ? OFF_SKV1 : OFF_SKV2;
            *(f32x4*)(F.out() + offs + ((size_t)(j * 256 + row) * 2 + (part - 1)) * 1024 + (col % 1024)) = v; } } };
struct SEpiSW { static constexpr bool HAS_FINISH = false; float* O; int ldc;
    struct Pre { int dummy; };
    __device__ __forceinline__ Pre ld(int, int) const { Pre p; p.dummy = 0; return p; }
    __device__ __forceinline__ void st(const f32x4& v, const Pre&, int row, int col) const { if (row < 36) *(f32x4*)(O + (size_t)row * ldc + col) = v; } };
__device__ __forceinline__ void flush_caches(Frame& F) {
    const float* src = F.cache2() + (size_t)F.vcu * 524288;
    f32x4 acc = (f32x4){0.f, 0.f, 0.f, 0.f};
    for (int i = F.tid; i < 131072; i += 512) acc = acc + *(const f32x4*)(src + (size_t)i * 4);
    if (acc.x + acc.y + acc.z + acc.w == 12345.678f) F.lse()[0] = acc.x;
}
#ifndef MK_PER_PHASE
#define MK_PER_PHASE 0
#endif
constexpr int NPHASES = 18;
__global__ void __launch_bounds__(NWAVES * 64, 2) fwd_kernel(Args args) {
    extern __shared__ __attribute__((aligned(16))) unsigned char lds[];
    Frame F;
    F.lds = (LAS unsigned char*)lds;
    F.MISC = (volatile LAS unsigned*)(F.lds + MISC_OFF);
    F.tid = threadIdx.x;
    F.G = gridDim.x; { const int bx = blockIdx.x; F.vcu = (F.G % 8 == 0) ? (bx % 8) * (F.G / 8) + bx / 8 : bx; }
    F.A = (const __attribute__((address_space(4))) Args*)__builtin_amdgcn_kernarg_segment_ptr(); F.ws = args.ws; F.sA = 0; F.sO = 0;
    for (int u = F.tid; u < (LDS_BYTES - LDSCTL_OFF) / 4; u += NWAVES * 64) ((LAS unsigned*)(F.lds + LDSCTL_OFF))[u] = 0u;
    __syncthreads();
    const int lo = args.ph_lo, hi = args.ph_hi;
    XcdBarrier bar; bar.bar = (unsigned*)(F.ctl() + CW_BAR); bar.x = 0; bar.st = nullptr;
    if (hi - lo > 1) bar = xcd_barrier_post((unsigned*)(F.ctl() + CW_BAR), F.MISC + 8);
#ifndef PHMASK
#define PHMASK 0xFFF
#endif
#define IN(k) (lo <= (k) && (k) < hi)
#define WAVE_ID() __builtin_amdgcn_readfirstlane(F.tid >> 6)
#define LAUNDER() do { F.A = (const __attribute__((address_space(4))) Args*)(unsigned long long)launder_ptr((const void*)(unsigned long long)F.A); F.ws = (unsigned char*)launder_ptr(F.ws); } while (0)
#ifndef SKIPMASK
#define SKIPMASK 0
#endif
#define EN(b) (((PHMASK >> (b)) & 1) && !(((SKIPMASK >> (b)) & 1) && pass == NPASS - 1 && NPASS > 1 && skipjj))
#ifndef REPMASK
#define REPMASK 0
#endif
#define REP(b) (((REPMASK >> (b)) & 1) ? 2 : 1)
#ifndef FLUSHMASK
#define FLUSHMASK 0
#endif
#define FLUSH(b) do { if ((FLUSHMASK >> (b)) & 1) { XcdBarrier b3 = bar; b3.bar = (unsigned*)launder_ptr(b3.bar); xcd_barrier(b3); flush_caches(F); xcd_barrier(b3); } } while (0)
#define SEAM(k) do { if (IN(k) && IN((k) + 1)) { XcdBarrier b2 = bar; b2.bar = (unsigned*)launder_ptr(b2.bar); xcd_barrier(b2); if (REPMASK & 0x10000) xcd_barrier(b2); } } while (0)

#ifndef NPASS
#define NPASS 1
#endif
    const bool fusef = (F.G >= 256) && IN(16) && IN(17);
    for (int pass = 0; pass < NPASS; ++pass) {
    bool skipjj = true;
    if (pass > 0) { XcdBarrier b2 = bar; b2.bar = (unsigned*)launder_ptr(b2.bar); xcd_barrier(b2);
        for (int i = F.vcu * 512 + F.tid; i < 4 * MALL; i += F.G * 512) F.RSS(0)[i] = 0.f; xcd_barrier(b2); }
    LAUNDER(); if (EN(0) && IN(0)) { _Pragma("nounroll") for (int rep = 0; rep < REP(0); ++rep) { p0_prologue(F); __syncthreads(); } } SEAM(0);
    for (int jj = 0; jj < 2; ++jj) {
        const int pb = 1 + 8 * jj; skipjj = (jj == 1); F.sA = 2 * jj; F.sO = jj;
        const int l0 = 2 * jj, l1 = 2 * jj + 1;
        if (jj == 0) { LAUNDER(); if (EN(1) && IN(pb + 0)) { norm_phase(F, 0); } SEAM(pb + 0); }
        LAUNDER(); if (EN(2) && IN(pb + 1)) {
            pg8::Gemm g{F.H(), F.lwin_t() + (size_t)jj * 3072 * 1024, MP, 3072, 1024}; pg8::StaticOrder S; S.init(MP, 3072, F.G, (int)blockIdx.x);
            pg8::EpiXg E{F, l0, jj != 0, MALL};
            pg8::gemm_phase<pg8::EpiXg, pg8::StaticOrder, true, true>(F.lds + RING_OFF, g, S, E);
            const SEpiXg SE{F, l0, jj != 0};
            for (int u = F.vcu; u < 48; u += F.G) sgemm_unit<4>(F, F.H() + (size_t)MP * 1024, F.lwin_t() + (size_t)jj * 3072 * 1024, 1024, 64 * u, SE);
            if (F.vcu >= 48) conv_items(F, jj, CV_LIN, CV_AIN, F.vcu - 48, F.G - 48);
        } SEAM(pb + 1);
        LAUNDER(); if (EN(4) && IN(pb + 2)) { scan_phase(F, jj); __syncthreads(); } SEAM(pb + 2);
        LAUNDER(); if (EN(5) && IN(pb + 3)) {
            pg8::Gemm g{F.Y(), F.lwout_t() + (size_t)jj * 1024 * 1536, MP, 1024, 1536}; pg8::StaticOrder S; S.init(MP, 1024, F.G, (int)blockIdx.x);
            pg8::EpiResid E{F, l0, true};
            pg8::gemm_phase<pg8::EpiResid, pg8::StaticOrder, true, true>(F.lds + RING_OFF, g, S, E);
            const SEpiResid SE{F, l0, true, false};
            for (int u = F.vcu; u < 16; u += F.G) sgemm_unit<4>(F, F.Y() + (size_t)MP * 1536, F.lwout_t() + (size_t)jj * 1024 * 1536, 1536, 64 * u, SE);
            const SEpiSW SW1{F.SW(l1), 10240};
            for (int u = F.vcu - 16; u >= 0 && u < 160; u += F.G) sgemm_unit<4>(F, F.SHB(l1), F.awin_t() + (size_t)jj * 10240 * 1024, 1024, 64 * u, SW1);
        } SEAM(pb + 3);
        F.sA = 2 * jj + 1;
        LAUNDER(); if (EN(6) && IN(pb + 4)) {
            pg8::Gemm g{F.H(), F.awin_t() + (size_t)jj * 10240 * 1024, MP, 10240, 1024}; pg8::StaticOrder S; S.init(MP, 10240, F.G, (int)blockIdx.x);
            pg8::EpiQkv E{F, l1, jj};
            pg8::gemm_phase<pg8::EpiQkv, pg8::StaticOrder, true, true>(F.lds + RING_OFF, g, S, E);
            const SEpiQkv SE{F, l1, jj};
            for (int u = F.vcu; u < 160; u += F.G) sgemm_unit<4>(F, F.H() + (size_t)MP * 1024, F.awin_t() + (size_t)jj * 10240 * 1024, 1024, 64 * u, SE);
            if (F.vcu >= 160) { conv_items(F, jj, CV_AIN, CV_AOUT, F.vcu - 160, F.G - 160);
                if (jj == 0) conv_items(F, 1, 0, CV_LIN, F.vcu - 160, F.G - 160); }
        } SEAM(pb + 4);
        _Pragma("nounroll") for (int sub = 0; sub < 2; ++sub) {
            LAUNDER(); if (EN(7) && IN(pb + 5 + sub)) { attn_phase(F, sub, jj); if (sub == 1) __syncthreads(); } SEAM(pb + 5 + sub);
        }
        LAUNDER(); if (EN(10) && IN(pb + 7)) {
            pg8::Gemm g{F.Y(), F.awout_t() + (size_t)jj * 1024 * 1024, MP, 1024, 1024}; pg8::StaticOrder S; S.init(MP, 1024, F.G, (int)blockIdx.x);
            if (jj == 1 && fusef) { pg8::EpiFinal E{F, l1}; pg8::gemm_phase<pg8::EpiFinal, pg8::StaticOrder, true, true>(F.lds + RING_OFF, g, S, E); }
            else { pg8::EpiResid E{F, l1, jj == 0}; pg8::gemm_phase<pg8::EpiResid, pg8::StaticOrder, true, true>(F.lds + RING_OFF, g, S, E); }
            const SEpiResid SE{F, l1, jj == 0, jj == 1 && fusef};
            for (int u = F.vcu; u < 16; u += F.G) sgemm_unit<4>(F, F.Y() + (size_t)MP * 1024, F.awout_t() + (size_t)jj * 1024 * 1024, 1024, 64 * u, SE);
            const SEpiSW SW2{F.SW(2), 3072};
            if (jj == 0) for (int u = F.vcu - 16; u >= 0 && u < 48; u += F.G) sgemm_unit<4>(F, F.SHB(2), F.lwin_t() + (size_t)3072 * 1024, 1024, 64 * u, SW2);
        } if (!(jj == 1 && fusef)) SEAM(pb + 7);
    }
    skipjj = true;
    LAUNDER(); if (EN(11) && IN(17) && !fusef) { _Pragma("nounroll") for (int rep = 0; rep < REP(11); ++rep) final_phase(F); }
    FLUSH(12);
    }
#undef IN
#undef WAVE_ID
#undef LAUNDER
#undef EN
#undef REP
#undef FLUSH
#undef SEAM
}

extern "C" void kernel_launch(void* const* d_in, const int* in_sizes, int n_in, void* d_out, int out_size, void* d_ws, size_t ws_size, hipStream_t stream) {
    static int grid = 0;
    if (grid == 0) {
        if (n_in != 24 || out_size != (int)OUT_TOTAL || ws_size < WS_END) { fprintf(stderr, "kernel_launch: unexpected shapes: n_in %d out %d ws %zu; nothing launched\n", n_in, out_size, ws_size); grid = -1; return; }
        int dev = 0, cus = 0, per_cu = 0;
        if (hipGetDevice(&dev) != hipSuccess || hipDeviceGetAttribute(&cus, hipDeviceAttributeMultiprocessorCount, dev) != hipSuccess) { fprintf(stderr, "kernel_launch: device query failed\n"); grid = -1; return; }
        if (hipFuncSetAttribute((const void*)fwd_kernel, hipFuncAttributeMaxDynamicSharedMemorySize, LDS_BYTES) != hipSuccess) { fprintf(stderr, "kernel_launch: hipFuncSetAttribute failed\n"); grid = -1; return; }
        if (hipOccupancyMaxActiveBlocksPerMultiprocessor(&per_cu, (const void*)fwd_kernel, NWAVES * 64, LDS_BYTES) != hipSuccess || per_cu < 1)
            fprintf(stderr, "kernel_launch: note: occupancy query reports %d workgroups per CU\n", per_cu);
        (void)hipGetLastError();
        grid = cus;
    }
    if (grid < 0) return;
    if (hipMemsetAsync((char*)d_ws + WS_CARRY, 0, CARRY_BYTES, stream) != hipSuccess || hipMemsetAsync((char*)d_ws + WS_CTL, 0, CTL_ZERO_BYTES, stream) != hipSuccess) { fprintf(stderr, "kernel_launch: memset failed\n"); return; }
    Args a{};
    for (int i = 0; i < 24; ++i) a.in[i] = (const float*)d_in[i];
    a.outp = (float*)d_out; a.ws = (unsigned char*)d_ws;
#if MK_PER_PHASE
    for (int p = 0; p < NPHASES; ++p) { a.ph_lo = p; a.ph_hi = p + 1; hipLaunchKernelGGL(fwd_kernel, dim3(grid), dim3(NWAVES * 64), LDS_BYTES, stream, a); }
#else
    a.ph_lo = 0; a.ph_hi = NPHASES;
    hipLaunchKernelGGL(fwd_kernel, dim3(grid), dim3(NWAVES * 64), LDS_BYTES, stream, a);
#endif
    const hipError_t le = hipPeekAtLastError();
    if (le != hipSuccess) fprintf(stderr, "kernel_launch: launch failed: %s\n", hipGetErrorName(le));
}
```

```cpp
#include <hip/hip_runtime.h>
#include <cstdio>
#include <cstdint>
#define MK_PER_PHASE 0
namespace pg8 {
#define PG8_LAS __attribute__((address_space(3)))
typedef unsigned short bf16_t;
typedef short bf16x8 __attribute__((ext_vector_type(8)));
typedef float f32x4 __attribute__((ext_vector_type(4)));
typedef unsigned u32x4 __attribute__((ext_vector_type(4)));
constexpr int BM = 256, BK = 64, HALF = 128, HTB = HALF * BK * 2  , STAGE_BYTES = 8 * HTB, NXCD = 8, WGM = 4;

__host__ __device__ __forceinline__ int lds_byte(int r, int c) { const int st = (r >> 4) * 2 + (c >> 5), rr = r & 15, cc = c & 31, ob = rr * 64 + cc * 2; return st * 1024 + (ob ^ (((ob >> 9) & 1) << 5)); }
__host__ __device__ __forceinline__ void stage_rc(int b, int& R, int& C) { const int st = b / 1024, sb = b % 1024, swz = sb ^ (((sb >> 9) & 1) << 5); R = (st >> 1) * 16 + swz / 64; C = (st & 1) * 32 + (swz % 64) / 2; }
__host__ __device__ __forceinline__ int perm32(int rho) { const int n = rho >> 4, i = rho & 15; return 8 * (i >> 2) + 4 * n + (i & 3); }

struct Unit { int pm, pn; };
struct Gemm { const bf16_t* A; const bf16_t* Bt; int M, N, K; };

struct StaticOrder {
    int nM, nN, nwg, G, c, rot;
    __host__ __device__ void init(int M, int N, int G_, int c_, int rot_ = 0) { nM = M / BM; nN = N / BM; nwg = nM * nN; G = G_; c = c_; rot = rot_; }
    __host__ __device__ bool next(int i, Unit& u) const {
        const long L = (long)i * G + c; if (L >= nwg) return false;
        int wgid = (int)L; { const int q = nwg / NXCD, r = nwg % NXCD, xcd = wgid % NXCD, off = wgid / NXCD; wgid = (xcd < r ? xcd * (q + 1) : r * (q + 1) + (xcd - r) * q) + off; }
        const int nig = WGM * nN, gid = wgid / nig, fm = gid * WGM, gsz = (nM - fm) < WGM ? (nM - fm) : WGM;
        u.pm = fm + ((wgid % nig) % gsz); u.pn = (wgid % nig) / gsz + rot; if (u.pn >= nN) u.pn -= nN; return true;
    }
    __device__ __forceinline__ void a_ready(const Unit&) const {}
    __device__ __forceinline__ void done(const Unit&) const {}
};

__device__ __forceinline__ unsigned cvt_pk_bf16(float lo, float hi) { unsigned r; asm volatile("v_cvt_pk_bf16_f32 %0, %1, %2" : "=v"(r) : "v"(lo), "v"(hi)); return r; }
typedef float f32x2 __attribute__((ext_vector_type(2)));
__device__ __forceinline__ f32x2 gelu_pk(f32x2 v) {
    const f32x2 av = __builtin_elementwise_abs(v), d = av * 0.2316418882f + 1.0f;
    f32x2 t; t.x = __builtin_amdgcn_rcpf(d.x); t.y = __builtin_amdgcn_rcpf(d.y);
    f32x2 q = t * 0.5307027145f + (-0.7265760135f); q = q * t + 0.7107068705f; q = q * t + (-0.142248368f); q = q * t + 0.127414796f; q = q * t;
    const f32x2 s = (v * v) * (-0.72134752044f);
    f32x2 e; e.x = __builtin_amdgcn_exp2f(s.x); e.y = __builtin_amdgcn_exp2f(s.y);
    const f32x2 m = v * (q * e), r = v - m;
    f32x2 o; o.x = v.x < 0.f ? m.x : r.x; o.y = v.y < 0.f ? m.y : r.y; return o;
}

template <int ACT  > struct EpiBf16 {
    static constexpr bool PERM = true, AFTER_DRAIN = false, PREFETCH = false; static_assert(ACT == 0 || ACT == 1, "EpiBf16: ACT is 0 (none) or 1 (gelu_pk)");
    bf16_t* O; int ldc; const float* bias; int split_cols; size_t split_stride; float scale0;
    __device__ __forceinline__ void operator()(const f32x4 (&acc)[2][2][4][2], const Unit& u, int wr, int wc, int fr, int fq) const {
        const int row0 = u.pm * BM + wr * 64 + fr; int colt = u.pn * BM; bf16_t* base = O;
        float sc = 1.f; if (split_cols) { const int t = colt / split_cols; base += (size_t)t * split_stride; colt -= t * split_cols; if (t == 0) sc = scale0; }
        const int col0 = colt + wc * 32 + 8 * fq, bcol0 = u.pn * BM + wc * 32 + 8 * fq;
        f32x4 bv[2][2];
#pragma unroll
        for (int bj = 0; bj < 2; ++bj)
#pragma unroll
            for (int n = 0; n < 2; ++n) bv[bj][n] = bias ? *(const f32x4*)(bias + bcol0 + bj * HALF + 4 * n) : (f32x4){0.f, 0.f, 0.f, 0.f};
#pragma unroll
        for (int ai = 0; ai < 2; ++ai)
#pragma unroll
            for (int m = 0; m < 4; ++m) { bf16_t* rowp = base + (size_t)(row0 + ai * HALF + m * 16) * ldc + col0;
#pragma unroll
                for (int bj = 0; bj < 2; ++bj) { f32x4 v0 = acc[ai][bj][m][0] + bv[bj][0], v1 = acc[ai][bj][m][1] + bv[bj][1];
                    if (ACT == 1) { f32x2 a = gelu_pk((f32x2){v0[0], v0[1]}), b = gelu_pk((f32x2){v0[2], v0[3]}), c = gelu_pk((f32x2){v1[0], v1[1]}), d = gelu_pk((f32x2){v1[2], v1[3]});
                        v0 = (f32x4){a.x, a.y, b.x, b.y}; v1 = (f32x4){c.x, c.y, d.x, d.y}; }
                    v0 = v0 * sc; v1 = v1 * sc; u32x4 w; w.x = cvt_pk_bf16(v0[0], v0[1]); w.y = cvt_pk_bf16(v0[2], v0[3]); w.z = cvt_pk_bf16(v1[0], v1[1]); w.w = cvt_pk_bf16(v1[2], v1[3]);
                    *(u32x4*)(rowp + bj * HALF) = w; } }
    }
};
template <class Epi, class Sched, bool ALIGN_EPI = false, bool SP2 = false>
__device__ __forceinline__ void gemm_phase(PG8_LAS unsigned char* lds, const Gemm g, const Sched& S, const Epi& E) {
    int tid_ = threadIdx.x; asm volatile("" : "+v"(tid_));
    const int tid = tid_, wid = __builtin_amdgcn_readfirstlane(tid >> 6), lane = tid & 63, wr = wid >> 2, wc = wid & 3, fr = lane & 15, fq = lane >> 4;
    const int K = g.K, nt = K / BK;
    unsigned voffA[2], voffB[2];
#pragma unroll
    for (int i = 0; i < 2; ++i) { int R, C; stage_rc(tid * 16 + i * 8192, R, C); const int Rb = Epi::PERM ? ((R & ~31) + perm32(R & 31)) : R;
        voffA[i] = (unsigned)(R * K + C) * 2u; voffB[i] = (unsigned)(Rb * K + C) * 2u; }
    const size_t kstep = (size_t)(BK * 2);
    const size_t hstep = (size_t)HALF * K * 2;
    const size_t tstep = 2 * hstep;
    const unsigned ldsw = (unsigned)wid * 1024u;
    const int aoff = lds_byte(wr * 64 + fr, fq * 8), boff = lds_byte(wc * 32 + fr, fq * 8);
#define PG8_SA(b, h) (((b) * 2 + (h)) * HTB)
#define PG8_SB(b, h) ((4 + (b) * 2 + (h)) * HTB)
#define PG8_STAGE(bufoff, gbase, voff) do { _Pragma("unroll") for (int _i = 0; _i < 2; ++_i) \
        __builtin_amdgcn_global_load_lds((const unsigned*)((const char*)(gbase) + (voff)[_i]), (PG8_LAS unsigned*)(lds + (bufoff) + ldsw + _i * 8192), 16, 0, 0); } while (0)
#define PG8_LDA(dst, b, h) do { _Pragma("unroll") for (int m = 0; m < 4; ++m) _Pragma("unroll") for (int k = 0; k < 2; ++k) dst[m][k] = *(const PG8_LAS bf16x8*)(lds + PG8_SA(b, h) + aoff + m * 2048 + k * 1024); } while (0)
#define PG8_LDB(dst, b, h) do { _Pragma("unroll") for (int n = 0; n < 2; ++n) _Pragma("unroll") for (int k = 0; k < 2; ++k) dst[n][k] = *(const PG8_LAS bf16x8*)(lds + PG8_SB(b, h) + boff + n * 2048 + k * 1024); } while (0)
#define PG8_MMA(ai, bj, At, Bt) do { __builtin_amdgcn_s_setprio(1); _Pragma("unroll") for (int m = 0; m < 4; ++m) _Pragma("unroll") for (int n = 0; n < 2; ++n) _Pragma("unroll") for (int k = 0; k < 2; ++k) \
        acc[ai][bj][m][n] = __builtin_amdgcn_mfma_f32_16x16x32_bf16(Bt[n][k], At[m][k], acc[ai][bj][m][n], 0, 0, 0); __builtin_amdgcn_s_setprio(0); } while (0)
#define PG8_WAIT_V(n) asm volatile("s_waitcnt vmcnt(" #n ")" ::: "memory")
#define PG8_WAIT_L(n) asm volatile("s_waitcnt lgkmcnt(" #n ")" ::: "memory")
#define PG8_BAR __builtin_amdgcn_s_barrier()
#define PG8_SCHED __builtin_amdgcn_sched_barrier(0)
    Unit cur, nxt; int ui = 0;
    if (!S.next(0, cur)) return;
    f32x4 acc[2][2][4][2];
#pragma unroll
    for (int a = 0; a < 2; ++a)
#pragma unroll
        for (int b = 0; b < 2; ++b)
#pragma unroll
            for (int m = 0; m < 4; ++m)
#pragma unroll
                for (int n = 0; n < 2; ++n) acc[a][b][m][n] = (f32x4){0.f, 0.f, 0.f, 0.f};
    bf16x8 At[4][2], B0[2][2], B1[2][2];
    const char* cA = (const char*)g.A + (size_t)cur.pm * tstep; const char* cB = (const char*)g.Bt + (size_t)cur.pn * tstep;
    S.a_ready(cur);
    if constexpr (SP2) {
        PG8_STAGE(PG8_SB(0, 0), cB, voffB); PG8_STAGE(PG8_SB(0, 1), cB + hstep, voffB); PG8_STAGE(PG8_SA(0, 0), cA, voffA); PG8_STAGE(PG8_SA(0, 1), cA + hstep, voffA);
        if (wr == 1) PG8_BAR;
        PG8_WAIT_V(2); PG8_BAR;
        PG8_STAGE(PG8_SB(1, 0), cB + kstep, voffB); PG8_STAGE(PG8_SA(1, 0), cA + kstep, voffA); PG8_STAGE(PG8_SB(1, 1), cB + hstep + kstep, voffB);
        PG8_WAIT_V(6); PG8_BAR;
    } else {
        PG8_STAGE(PG8_SB(0, 0), cB, voffB); PG8_STAGE(PG8_SA(0, 0), cA, voffA); PG8_STAGE(PG8_SB(0, 1), cB + hstep, voffB); PG8_STAGE(PG8_SA(0, 1), cA + hstep, voffA);
        if (wr == 1) PG8_BAR;
        PG8_WAIT_V(4); PG8_BAR;
        PG8_STAGE(PG8_SB(1, 0), cB + kstep, voffB); PG8_STAGE(PG8_SA(1, 0), cA + kstep, voffA); PG8_STAGE(PG8_SB(1, 1), cB + hstep + kstep, voffB);
        PG8_WAIT_V(6); PG8_BAR;
    }
    for (;;) {
        const bool has_next = S.next(ui + 1, nxt);
        const char* nA = has_next ? (const char*)g.A + (size_t)nxt.pm * tstep : cA; const char* nB = has_next ? (const char*)g.Bt + (size_t)nxt.pn * tstep : cB;
        for (int t = 0; t < nt; t += 2) {
            const bool last = (t == nt - 2);
            const char* a1 = cA + (size_t)(t + 1) * kstep;
            const char* a2 = last ? nA : cA + (size_t)(t + 2) * kstep; const char* b2 = last ? nB : cB + (size_t)(t + 2) * kstep;
            const char* a3 = a2 + kstep; const char* b3 = b2 + kstep;
            if constexpr (Epi::PREFETCH) { if (t < 16) E.prefetch(cur, t >> 1, wid, wr, wc, lane); }
            if (last && has_next) S.a_ready(nxt);
            if constexpr (SP2) {
            PG8_LDB(B0, 0, 0); PG8_LDB(B1, 0, 1); PG8_SCHED; PG8_LDA(At, 0, 0); PG8_STAGE(PG8_SA(1, 1), a1 + hstep, voffA);
            PG8_WAIT_V(8); PG8_WAIT_L(0); PG8_BAR; PG8_MMA(0, 0, At, B0); PG8_MMA(0, 1, At, B1); PG8_BAR; PG8_SCHED;
            PG8_LDA(At, 0, 1); PG8_STAGE(PG8_SB(0, 0), b2, voffB); PG8_STAGE(PG8_SB(0, 1), b2 + hstep, voffB); PG8_STAGE(PG8_SA(0, 0), a2, voffA);
            PG8_WAIT_V(8); PG8_WAIT_L(0); PG8_BAR; PG8_MMA(1, 0, At, B0); PG8_MMA(1, 1, At, B1); PG8_BAR; PG8_SCHED;
            PG8_LDB(B0, 1, 0); PG8_LDB(B1, 1, 1); PG8_SCHED; PG8_LDA(At, 1, 0); PG8_STAGE(PG8_SA(0, 1), a2 + hstep, voffA);
            PG8_WAIT_V(8); PG8_WAIT_L(0); PG8_BAR; PG8_MMA(0, 0, At, B0); PG8_MMA(0, 1, At, B1); PG8_BAR; PG8_SCHED;
            PG8_LDA(At, 1, 1); PG8_STAGE(PG8_SB(1, 0), b3, voffB); PG8_STAGE(PG8_SB(1, 1), b3 + hstep, voffB); PG8_STAGE(PG8_SA(1, 0), a3, voffA);
            PG8_WAIT_V(8); PG8_WAIT_L(0); PG8_BAR; PG8_MMA(1, 0, At, B0); PG8_MMA(1, 1, At, B1); PG8_BAR; PG8_SCHED;
            } else {
            PG8_LDB(B0, 0, 0); PG8_SCHED; PG8_LDA(At, 0, 0); PG8_STAGE(PG8_SA(1, 1), a1 + hstep, voffA);
            PG8_WAIT_L(8); PG8_BAR; PG8_WAIT_L(0); PG8_MMA(0, 0, At, B0); PG8_BAR; PG8_SCHED;
            PG8_LDB(B1, 0, 1); PG8_STAGE(PG8_SB(0, 0), b2, voffB);
            PG8_BAR; PG8_WAIT_L(0); PG8_MMA(0, 1, At, B1); PG8_BAR;
            PG8_LDA(At, 0, 1); PG8_STAGE(PG8_SA(0, 0), a2, voffA);
            PG8_BAR; PG8_WAIT_L(0); PG8_MMA(1, 0, At, B0); PG8_BAR; PG8_SCHED;
            PG8_STAGE(PG8_SB(0, 1), b2 + hstep, voffB);
            PG8_WAIT_V(6); PG8_BAR; PG8_MMA(1, 1, At, B1); PG8_BAR;
            PG8_LDB(B0, 1, 0); PG8_SCHED; PG8_LDA(At, 1, 0); PG8_STAGE(PG8_SA(0, 1), a2 + hstep, voffA);
            PG8_WAIT_L(8); PG8_BAR; PG8_WAIT_L(0); PG8_MMA(0, 0, At, B0); PG8_BAR; PG8_SCHED;
            PG8_LDB(B1, 1, 1); PG8_STAGE(PG8_SB(1, 0), b3, voffB);
            PG8_BAR; PG8_WAIT_L(0); PG8_MMA(0, 1, At, B1); PG8_BAR;
            PG8_LDA(At, 1, 1); PG8_STAGE(PG8_SA(1, 0), a3, voffA);
            PG8_BAR; PG8_WAIT_L(0); PG8_MMA(1, 0, At, B0); PG8_BAR; PG8_SCHED;
            PG8_STAGE(PG8_SB(1, 1), b3 + hstep, voffB);
            PG8_WAIT_V(6); PG8_BAR; PG8_MMA(1, 1, At, B1); PG8_BAR;
            }
        }
        if constexpr (ALIGN_EPI) { if (wr == 0) PG8_BAR; }
        if constexpr (!Epi::AFTER_DRAIN) { E(acc, cur, wr, wc, fr, fq); S.done(cur); }
        if (!has_next) break;
#pragma unroll
        for (int a = 0; a < 2; ++a)
#pragma unroll
            for (int b = 0; b < 2; ++b)
#pragma unroll
                for (int m = 0; m < 4; ++m)
#pragma unroll
                    for (int n = 0; n < 2; ++n) acc[a][b][m][n] = (f32x4){0.f, 0.f, 0.f, 0.f};
        cur = nxt; cA = nA; cB = nB; ++ui;
        if constexpr (ALIGN_EPI) { if (wr == 1) PG8_BAR; }
    }
    PG8_WAIT_V(0);
    if constexpr (!ALIGN_EPI) { if (wr == 0) PG8_BAR; }
    PG8_BAR;
    if constexpr (Epi::AFTER_DRAIN) { E.fused(acc, cur, wr, wc, fr, fq, lds, wid, lane); S.done(cur); }
#undef PG8_SA
#undef PG8_SB
#undef PG8_STAGE
#undef PG8_LDA
#undef PG8_LDB
#undef PG8_MMA
#undef PG8_WAIT_V
#undef PG8_WAIT_L
#undef PG8_BAR
#undef PG8_SCHED
}
}
#ifndef REPMASK
#define REPMASK 0
#endif
constexpr int NWAVES = 8;
constexpr int D = 1024, MP = 16384, MS = 256, MALL = MP + MS, SEQ = 4096, DR = 1536, NQKVG = 10240;
constexpr float EPS = 1e-6f;
constexpr float LOG2E = 1.4426950408889634f, LN2 = 0.6931471805599453f;
constexpr size_t OFF_YP = 0, OFF_YS = 16777216, OFF_PCONV = 17039360, OFF_PH = 17076224, OFF_PKV0 = 17088512, OFF_PKV1 = 19185664, OFF_PKV2 = 27574272,
                 OFF_SCONV = 61128704, OFF_SH = 61423616, OFF_SKV0 = 61521920, OFF_SKV1 = 62570496, OFF_SKV2 = 63619072, OUT_TOTAL = 64667648;
constexpr size_t MiB = 1u << 20;
constexpr size_t WS_CTL = 0, CTL_ZERO_BYTES = 1 * MiB;
constexpr size_t WS_MOD = 1 * MiB;
constexpr size_t WS_WAT = 3 * MiB, WS_WXT = 4 * MiB;
constexpr size_t WS_AGG = 5 * MiB;
constexpr size_t WS_LSE = 7 * MiB;
constexpr size_t WS_SO = 9 * MiB;
constexpr size_t WS_SLSE = 15 * MiB;
constexpr size_t WS_LWIN = 16 * MiB;
constexpr size_t WS_LWOUT = 28 * MiB;
constexpr size_t WS_AWOUT = 34 * MiB;
constexpr size_t WS_AWIN = 38 * MiB;
constexpr size_t WS_X = 80 * MiB;
constexpr size_t WS_H = 146 * MiB;
constexpr size_t WS_Y = 180 * MiB;
constexpr size_t WS_OACC = 230 * MiB;
constexpr size_t WS_XG = 296 * MiB;
constexpr size_t WS_QS = 616 * MiB;
constexpr size_t WS_SW = 628 * MiB;
constexpr size_t WS_SHB = 636 * MiB;
constexpr size_t CTL_RSS = 524288;
constexpr size_t WS_CARRY = 624 * MiB, CARRY_BYTES = 2 * 64 * 1536 * 16;
#ifndef SEPBUF
#define SEPBUF 0
#endif
constexpr size_t WS_SEP = 700 * MiB;
constexpr size_t WS_END = SEPBUF ? (700 + 1930 + 280) * MiB : 640 * MiB;
constexpr int CW_TMO = 0, CW_BAR = 4096;
constexpr int CW_FIN = 65536, FIN_STRIDE = 32;
constexpr int RING_OFF = 0, RING_BYTES = 131072;
constexpr int LDS_BYTES = 163840;
constexpr int LDSCTL_OFF = LDS_BYTES - 1024, MISC_OFF = LDSCTL_OFF + 320;
constexpr int XPP = 208;
constexpr int ATT_V_OFF = 32768, ATT_VP = 144;

#define GAS __attribute__((address_space(1)))
#define LAS __attribute__((address_space(3)))
typedef unsigned short bf16;
typedef unsigned v4u __attribute__((ext_vector_type(4)));
typedef unsigned v2u __attribute__((ext_vector_type(2)));
typedef float f32x4 __attribute__((ext_vector_type(4)));
typedef float f32x2 __attribute__((ext_vector_type(2)));
typedef short bf16x8 __attribute__((ext_vector_type(8)));
typedef short s16x4 __attribute__((ext_vector_type(4)));
typedef GAS unsigned gu32;
#define RLX_AGENT __ATOMIC_RELAXED, __HIP_MEMORY_SCOPE_AGENT
#define LDS_WAIT() asm volatile("s_waitcnt lgkmcnt(0)" ::: "memory")
typedef float f32x2c_t __attribute__((ext_vector_type(2))); typedef __bf16 bf16x2c_t __attribute__((ext_vector_type(2)));
__device__ __forceinline__ unsigned pk2(float lo, float hi) { const f32x2c_t v = {lo, hi}; const bf16x2c_t b = __builtin_convertvector(v, bf16x2c_t); return __builtin_bit_cast(unsigned, b); }
__device__ __forceinline__ unsigned f2bf(float f) { return pk2(f, 0.f) & 0xffffu; }
__device__ __forceinline__ float bf2f(unsigned b) { return __builtin_bit_cast(float, b << 16); }
__device__ __forceinline__ float bflo(unsigned w) { return __builtin_bit_cast(float, w << 16); }
__device__ __forceinline__ float bfhi(unsigned w) { return __builtin_bit_cast(float, w & 0xffff0000u); }
__device__ __forceinline__ float sigmoid_f(float x) { return __builtin_amdgcn_rcpf(1.f + __builtin_amdgcn_exp2f(-LOG2E * x)); }
__device__ __forceinline__ float silu_f(float x) { return x * sigmoid_f(x); }
#define XB_TMO      128
#define XB_XCNT(j)  (256  + 64 * (j))
#define XB_XSUB(j)  (1280 + 64 * (j))
#define XB_XGEN(j)  (2304 + 64 * (j))
#define XB_TOP      3328
#define XB_TOPGEN   3392
#define XCD_BAR_WORDS 3456
#define XB_SPIN_CAP (1u << 18)

__device__ __forceinline__ unsigned xb_ld(unsigned* p)              { return __hip_atomic_load(p, __ATOMIC_RELAXED, __HIP_MEMORY_SCOPE_AGENT); }
__device__ __forceinline__ unsigned xb_add(unsigned* p, unsigned v) { return __hip_atomic_fetch_add(p, v, __ATOMIC_RELAXED, __HIP_MEMORY_SCOPE_AGENT); }
__device__ __forceinline__ unsigned xb_xcc_id() { return (unsigned)__builtin_amdgcn_s_getreg((3 << 11) | 20) & 0xFu; }
#define XB_SPIN(cond, bar) do { unsigned _sp = 0; while (cond) { __builtin_amdgcn_s_sleep(1); \
    if ((++_sp & 255u) == 0u) { if (xb_ld(&(bar)[XB_TMO])) break; if (_sp > XB_SPIN_CAP) { atomicAdd(&(bar)[XB_TMO], 1u); break; } } } } while (0)

struct XcdBarrier {
    unsigned* bar; unsigned x;
    volatile LAS unsigned* st;
};

__device__ __forceinline__ XcdBarrier xcd_barrier_post(unsigned* bar, volatile LAS unsigned* st) {
    XcdBarrier b; b.bar = bar; b.x = xb_xcc_id(); b.st = st;
    if (threadIdx.x == 0) (void)xb_add(&bar[XB_XCNT(b.x)], 1u);
    return b;
}
__device__ __forceinline__ void xcd_barrier_complete(unsigned* bar, unsigned x, unsigned& nloc, unsigned& nx) {
    const unsigned G = gridDim.x * gridDim.y * gridDim.z;
    unsigned sum, cnt, mine, sp = 0u;
    for (;;) {
        sum = 0u; cnt = 0u; mine = 0u;
#pragma unroll
        for (unsigned j = 0; j < 16; ++j) { const unsigned c = xb_ld(&bar[XB_XCNT(j)]); sum += c; cnt += (c > 0u) ? 1u : 0u; mine = (j == x) ? c : mine; }
        if (sum == G) break;
        __builtin_amdgcn_s_sleep(1);
        if ((++sp & 255u) == 0u) { if (xb_ld(&bar[XB_TMO])) break; if (sp > XB_SPIN_CAP) { atomicAdd(&bar[XB_TMO], 1u); break; } }
    }
    nloc = mine > 0u ? mine : 1u; nx = cnt > 0u ? cnt : 1u;
}

__device__ __forceinline__ void xcd_barrier(const XcdBarrier& b) {
    asm volatile("s_waitcnt vmcnt(0)" ::: "memory");
    __syncthreads();
    if (threadIdx.x == 0) {
        unsigned* bar = b.bar;
        __builtin_amdgcn_s_waitcnt(0);
        unsigned nloc = b.st[0], nx = b.st[1];
        if (nloc == 0u) { xcd_barrier_complete(bar, b.x, nloc, nx); b.st[0] = nloc; b.st[1] = nx; }
        const unsigned old = xb_add(&bar[XB_XSUB(b.x)], 1u);
        const unsigned gen = old / nloc;
        if (old + 1u == (gen + 1u) * nloc) {
            __builtin_amdgcn_fence(__ATOMIC_RELEASE, "agent");
            asm volatile("s_waitcnt vmcnt(0)" ::: "memory");
            const unsigned og = xb_add(&bar[XB_TOP], 1u);
            const unsigned tg = og / nx;
            if (og + 1u == (tg + 1u) * nx) xb_add(&bar[XB_TOPGEN], 1u);
            else XB_SPIN(xb_ld(&bar[XB_TOPGEN]) == tg, bar);
            __builtin_amdgcn_fence(__ATOMIC_ACQUIRE, "agent");
            xb_add(&bar[XB_XGEN(b.x)], 1u);
            asm volatile("s_waitcnt vmcnt(0)" ::: "memory");
        } else {
            XB_SPIN(xb_ld(&bar[XB_XGEN(b.x)]) == gen, bar);
            __builtin_amdgcn_fence(__ATOMIC_ACQUIRE, "agent");
            asm volatile("s_waitcnt vmcnt(0)" ::: "memory");
        }
    }
    __syncthreads();
}
__device__ __forceinline__ const void* launder_ptr(const void* p) {
    unsigned lo = (unsigned)(unsigned long long)p, hi = (unsigned)((unsigned long long)p >> 32);
    asm volatile("" : "+v"(lo), "+v"(hi));
    lo = __builtin_amdgcn_readfirstlane(lo); hi = __builtin_amdgcn_readfirstlane(hi);
    return (const void*)(((unsigned long long)hi << 32) | lo);
}
struct Args { const float* in[24]; float* outp; unsigned char* ws; int ph_lo, ph_hi; };
struct Frame {
    LAS unsigned char* lds;
    volatile LAS unsigned* MISC;
    int tid, vcu, G;
    int sA, sO;
    const __attribute__((address_space(4))) Args* A; unsigned char* ws;
    __device__ __forceinline__ float* out() const { return A->outp; }
    __device__ __forceinline__ gu32* ctl() const { return (gu32*)(ws + WS_CTL); }
    __device__ __forceinline__ const float* x_prompt() const { return A->in[0]; }
    __device__ __forceinline__ const float* x_sample() const { return A->in[1]; }
    __device__ __forceinline__ const float* state_conv() const { return A->in[2]; }
    __device__ __forceinline__ const float* state_h() const { return A->in[3]; }
    __device__ __forceinline__ const float* cache0() const { return A->in[4]; }
    __device__ __forceinline__ const float* cache1() const { return A->in[5]; }
    __device__ __forceinline__ const float* cache2() const { return A->in[6]; }
    __device__ __forceinline__ const float* c_prompt() const { return A->in[7]; }
    __device__ __forceinline__ const float* c_sample() const { return A->in[8]; }
    __device__ __forceinline__ const float* norm_g() const { return A->in[9]; }
    __device__ __forceinline__ const float* ada_w() const { return A->in[10]; }
    __device__ __forceinline__ const float* ada_b() const { return A->in[11]; }
    __device__ __forceinline__ const float* final_g() const { return A->in[12]; }
    __device__ __forceinline__ const float* lru_w_in() const { return A->in[13]; }
    __device__ __forceinline__ const float* lru_conv_w() const { return A->in[14]; }
    __device__ __forceinline__ const float* lru_conv_b() const { return A->in[15]; }
    __device__ __forceinline__ const float* lru_wa() const { return A->in[16]; }
    __device__ __forceinline__ const float* lru_ba() const { return A->in[17]; }
    __device__ __forceinline__ const float* lru_wx() const { return A->in[18]; }
    __device__ __forceinline__ const float* lru_bx() const { return A->in[19]; }
    __device__ __forceinline__ const float* lru_lambda() const { return A->in[20]; }
    __device__ __forceinline__ const float* lru_w_out() const { return A->in[21]; }
    __device__ __forceinline__ const float* att_w_in() const { return A->in[22]; }
    __device__ __forceinline__ const float* att_w_out() const { return A->in[23]; }
    __device__ __forceinline__ float* mod() const { return (float*)(ws + WS_MOD); }
    __device__ __forceinline__ bf16* wa_t() const { return (bf16*)(ws + WS_WAT); }
    __device__ __forceinline__ bf16* wx_t() const { return (bf16*)(ws + WS_WXT); }
    __device__ __forceinline__ f32x2* agg() const { return (f32x2*)(ws + WS_AGG); }
    __device__ __forceinline__ float* lse() const { return (float*)(ws + (SEPBUF ? WS_SEP + 1870 * MiB + (size_t)sO * (2 * MiB) : WS_LSE)); }
    __device__ __forceinline__ bf16* lwin_t() const { return (bf16*)(ws + WS_LWIN); }
    __device__ __forceinline__ bf16* lwout_t() const { return (bf16*)(ws + WS_LWOUT); }
    __device__ __forceinline__ bf16* awin_t() const { return (bf16*)(ws + WS_AWIN); }
    __device__ __forceinline__ bf16* awout_t() const { return (bf16*)(ws + WS_AWOUT); }
    __device__ __forceinline__ bf16* HN() const { return (bf16*)(ws + (SEPBUF ? WS_SEP + (size_t)(sA + 1) * (36 * MiB) : WS_H)); }
    __device__ __forceinline__ float* SW(int layer) const { return (float*)(ws + WS_SW) + (size_t)layer * 36 * 10240; }
    __device__ __forceinline__ bf16* SHB(int layer) const { return (bf16*)(ws + WS_SHB) + (size_t)layer * 256 * 1024; }
    __device__ __forceinline__ float* RSS(int layer) const { return (float*)(ws + WS_CTL + CTL_RSS) + (size_t)layer * MALL; }
    __device__ __forceinline__ unsigned long long* carry() const { return (unsigned long long*)(ws + WS_CARRY); }
    __device__ __forceinline__ float* X() const { return (float*)(ws + WS_X); }
    __device__ __forceinline__ float* XL(int layer) const { return (float*)(ws + (SEPBUF ? WS_SEP + 1930 * MiB + (size_t)layer * (70 * MiB) : WS_X)); }
    __device__ __forceinline__ bf16* H() const { return (bf16*)(ws + (SEPBUF ? WS_SEP + (size_t)sA * (36 * MiB) : WS_H)); }
    __device__ __forceinline__ bf16* Y() const { return (bf16*)(ws + (SEPBUF ? WS_SEP + 1500 * MiB + (size_t)sA * (52 * MiB) : WS_Y)); }
    __device__ __forceinline__ float* OACC() const { return (float*)(ws + (SEPBUF ? WS_SEP + 1720 * MiB + (size_t)sO * (70 * MiB) : WS_OACC)); }
    __device__ __forceinline__ bf16* XG() const { return (bf16*)(ws + (SEPBUF ? WS_SEP + 160 * MiB + (size_t)sA * (330 * MiB) : WS_XG)); }
    __device__ __forceinline__ bf16* QS() const { return (bf16*)(ws + (SEPBUF ? WS_SEP + 1910 * MiB + (size_t)sO * (6 * MiB) : WS_QS)); }
    __device__ __forceinline__ float* SO() const { return (float*)(ws + (SEPBUF ? WS_SEP + 1880 * MiB + (size_t)sO * (8 * MiB) : WS_SO)); }
    __device__ __forceinline__ float* SLSE() const { return (float*)(ws + (SEPBUF ? WS_SEP + 1900 * MiB + (size_t)sO * (1 * MiB) : WS_SLSE)); }
};

__device__ __forceinline__ void glds16(const void* gsrc, unsigned lds_dst) { unsigned keep;
    asm volatile("s_mov_b32 %0, m0\n\ts_mov_b32 m0, %2\n\ts_nop 0\n\tglobal_load_lds_dwordx4 %1, off\n\ts_mov_b32 m0, %0" : "=&s"(keep) : "v"(gsrc), "s"(lds_dst) : "memory"); }
__device__ __forceinline__ float shx(float v, int lane, int k) { return __builtin_bit_cast(float, __builtin_amdgcn_ds_bpermute((lane ^ k) << 2, __builtin_bit_cast(int, v))); }
__device__ __forceinline__ float shup(float v, int lane, int k) { const int src = lane >= k ? lane - k : lane; return __builtin_bit_cast(float, __builtin_amdgcn_ds_bpermute(src << 2, __builtin_bit_cast(int, v))); }
__device__ __forceinline__ float shl(float v, int src) { return __builtin_bit_cast(float, __builtin_amdgcn_ds_bpermute(src << 2, __builtin_bit_cast(int, v))); }
__device__ __forceinline__ float wave_sum(float v, int lane) {
#pragma unroll
    for (int o = 1; o < 64; o <<= 1) v += shx(v, lane, o);
    return v;
}
__device__ __forceinline__ void p0_transpose_item(const float* W, int K, int N, bf16* WT, LAS float* scr, int item, int lane) {
    const int nblk = N / 32, kb = item / nblk, nb = item % nblk, k0 = 64 * kb, n0 = 32 * nb;
    float wv[32];
#pragma unroll
    for (int i = 0; i < 32; ++i) { const int kk = 2 * i + (lane >> 5); wv[i] = W[(size_t)(k0 + kk) * N + n0 + (lane & 31)]; }
#pragma unroll
    for (int i = 0; i < 32; ++i) { const int kk = 2 * i + (lane >> 5); scr[kk * 33 + (lane & 31)] = wv[i]; }
    LDS_WAIT(); asm volatile("" ::: "memory");
    const int c = lane & 7;
#pragma unroll
    for (int j = 0; j < 4; ++j) { const int n = (lane >> 3) + 8 * j; const LAS float* s = scr + (8 * c) * 33 + n;
        v4u o; o.x = pk2(s[0 * 33], s[1 * 33]); o.y = pk2(s[2 * 33], s[3 * 33]); o.z = pk2(s[4 * 33], s[5 * 33]); o.w = pk2(s[6 * 33], s[7 * 33]);
        *(GAS v4u*)(WT + (size_t)(n0 + n) * K + k0 + 8 * c) = o; }
    LDS_WAIT(); asm volatile("" ::: "memory");
}

constexpr int CV_LIN = 16 * 96, CV_LOUT = CV_LIN + 24 * 32, CV_AIN = CV_LOUT + 16 * 320, CV_AOUT = CV_AIN + 16 * 32;
__device__ __forceinline__ void conv_items(Frame& F, int j, int lo, int hi, int rank, int nrank) {
    int tid_ = F.tid; asm volatile("" : "+v"(tid_));
    const int lane = tid_ & 63, wave = __builtin_amdgcn_readfirstlane(tid_ >> 6), wk = rank * NWAVES + wave, nwk = nrank * NWAVES;
    LAS float* scr = (LAS float*)(F.lds + RING_OFF + wave * 16384);
    for (int it = lo + wk; it < hi; it += nwk) {
        if (it < CV_LIN) p0_transpose_item(F.lru_w_in() + (size_t)j * 1024 * 3072, 1024, 3072, F.lwin_t() + (size_t)j * 3072 * 1024, scr, it, lane);
        else if (it < CV_LOUT) p0_transpose_item(F.lru_w_out() + (size_t)j * 1536 * 1024, 1536, 1024, F.lwout_t() + (size_t)j * 1024 * 1536, scr, it - CV_LIN, lane);
        else if (it < CV_AIN) p0_transpose_item(F.att_w_in() + (size_t)j * 1024 * 10240, 1024, 10240, F.awin_t() + (size_t)j * 10240 * 1024, scr, it - CV_LOUT, lane);
        else p0_transpose_item(F.att_w_out() + (size_t)j * 1024 * 1024, 1024, 1024, F.awout_t() + (size_t)j * 1024 * 1024, scr, it - CV_AIN, lane);
    }
}
__device__ __forceinline__ void p0_prologue(Frame& F) {
    LAS float* L = (LAS float*)(F.lds + RING_OFF);
    int tid_ = F.tid; asm volatile("" : "+v"(tid_));
    const int tid = tid_, p_lane = tid & 63, p_wave = __builtin_amdgcn_readfirstlane(tid >> 6);
    for (int u = F.vcu; u < 192; u += F.G) {
        const int layer = u / 48, n0 = (u % 48) * 64, col = tid & 63, kg = tid >> 6;
        float acc[36];
#pragma unroll
        for (int r = 0; r < 36; ++r) acc[r] = 0.f;
        for (int kh = 0; kh < 2; ++kh) {
            __syncthreads();
            { const int k = kh * 512 + tid; float cv[36];
#pragma unroll
              for (int r = 0; r < 36; ++r) cv[r] = (r < 4) ? F.c_prompt()[r * 1024 + k] : F.c_sample()[(r - 4) * 1024 + k];
#pragma unroll
              for (int r = 0; r < 36; ++r) L[tid * 36 + r] = silu_f(cv[r]); }
            __syncthreads();
            const float* wp = F.ada_w() + ((size_t)layer * 1024 + kh * 512 + kg * 64) * 3072 + n0 + col;
#pragma unroll 1
            for (int kl0 = 0; kl0 < 64; kl0 += 16) { float wv[16];
#pragma unroll
                for (int i = 0; i < 16; ++i) wv[i] = wp[(size_t)(kl0 + i) * 3072];
#pragma unroll
                for (int i = 0; i < 16; ++i) { const float w = wv[i]; const LAS f32x4* s4 = (const LAS f32x4*)(L + (kg * 64 + kl0 + i) * 36);
#pragma unroll
                    for (int q = 0; q < 9; ++q) { const f32x4 s = s4[q]; acc[4 * q] += s.x * w; acc[4 * q + 1] += s.y * w; acc[4 * q + 2] += s.z * w; acc[4 * q + 3] += s.w * w; } } }
        }
        __syncthreads();
#pragma unroll
        for (int r = 0; r < 36; ++r) L[(kg * 36 + r) * 64 + col] = acc[r];
        __syncthreads();
        for (int o = tid; o < 36 * 64; o += 512) { const int r = o >> 6, c = o & 63; float s = F.ada_b()[layer * 3072 + n0 + c];
#pragma unroll
            for (int g = 0; g < 8; ++g) s += L[(g * 36 + r) * 64 + c];
            F.mod()[((size_t)layer * 36 + r) * 3072 + n0 + c] = s;
            if (n0 < 1024) F.SHB(layer)[(size_t)r * 1024 + n0 + c] = (bf16)f2bf(s); }
        __syncthreads();
    }
    for (int e = F.vcu * 512 + tid; e < 2 * 16 * 9216; e += F.G * 512) { const int blk = e / 9216, rem = e % 9216, jj = rem / 96, i = rem % 96;
        F.wa_t()[e] = (bf16)f2bf(F.lru_wa()[(size_t)blk * 9216 + i * 96 + jj]); F.wx_t()[e] = (bf16)f2bf(F.lru_wx()[(size_t)blk * 9216 + i * 96 + jj]); }
    conv_items(F, 0, 0, CV_LIN, F.vcu, F.G);
}

__device__ __forceinline__ void norm_phase(Frame& F, int layer) {
    int tid_ = F.tid; asm volatile("" : "+v"(tid_));
    const int lane = tid_ & 63, wave = __builtin_amdgcn_readfirstlane(tid_ >> 6);
    const int gw = F.vcu * NWAVES + wave, NGW = F.G * NWAVES;
    const float* gp = F.norm_g() + layer * 1024; const float* mod = F.mod() + (size_t)layer * 36 * 3072;
    for (int m0 = gw; m0 < MALL; m0 += 2 * NGW) {
        const int m1 = (m0 + NGW < MALL) ? m0 + NGW : m0;
        f32x4 v[2][4];
#pragma unroll
        for (int r = 0; r < 2; ++r) { const int m = r ? m1 : m0; const bool sm = m >= MP;
            const float* xrow = (layer == 0) ? (sm ? F.x_sample() + (size_t)(m - MP) * 1024 : F.x_prompt() + (size_t)m * 1024) : F.XL(layer - 1) + (size_t)m * 1024;
            const GAS f32x4* xr = (const GAS f32x4*)xrow + lane;
#pragma unroll
            for (int q = 0; q < 4; ++q) v[r][q] = xr[64 * q]; }
#pragma unroll
        for (int r = 0; r < 2; ++r) { const int m = r ? m1 : m0; const bool sm = m >= MP; const int mr = sm ? 4 + ((m - MP) >> 3) : (m >> 12);
            float s = 0.f;
#pragma unroll
            for (int q = 0; q < 4; ++q) s += (v[r][q].x * v[r][q].x + v[r][q].y * v[r][q].y) + (v[r][q].z * v[r][q].z + v[r][q].w * v[r][q].w);
            const float rstd = rsqrtf(wave_sum(s, lane) * (1.f / 1024.f) + EPS);
            const float* mrow = mod + (size_t)mr * 3072;
            GAS v2u* o8 = (GAS v2u*)(F.H() + (size_t)m * 1024) + lane;
#pragma unroll
            for (int q = 0; q < 4; ++q) { const int c = 4 * lane + 256 * q;
                const f32x4 g4 = *(const f32x4*)(gp + c), sh = *(const f32x4*)(mrow + c), sc = *(const f32x4*)(mrow + 1024 + c);
                const f32x4 h = v[r][q] * rstd * g4 * (sc + 1.f) + sh;
                v2u w; w.x = pk2(h.x, h.y); w.y = pk2(h.z, h.w); o8[64 * q] = w; } }
    }
}
__device__ __forceinline__ void final_phase(Frame& F) {
    int tid_ = F.tid; asm volatile("" : "+v"(tid_));
    const int lane = tid_ & 63, wave = __builtin_amdgcn_readfirstlane(tid_ >> 6);
    const int gw = F.vcu * NWAVES + wave, NGW = F.G * NWAVES;
    for (int m0 = gw; m0 < MALL; m0 += 2 * NGW) {
        const int m1 = (m0 + NGW < MALL) ? m0 + NGW : m0;
        f32x4 v[2][4];
#pragma unroll
        for (int r = 0; r < 2; ++r) { const GAS f32x4* xr = (const GAS f32x4*)(F.XL(3) + (size_t)(r ? m1 : m0) * 1024) + lane;
#pragma unroll
            for (int q = 0; q < 4; ++q) v[r][q] = xr[64 * q]; }
#pragma unroll
        for (int r = 0; r < 2; ++r) { float s = 0.f;
#pragma unroll
            for (int q = 0; q < 4; ++q) s += (v[r][q].x * v[r][q].x + v[r][q].y * v[r][q].y) + (v[r][q].z * v[r][q].z + v[r][q].w * v[r][q].w);
            const float rstd = rsqrtf(wave_sum(s, lane) * (1.f / 1024.f) + EPS);
            GAS f32x4* o = (GAS f32x4*)(F.out() + (size_t)(r ? m1 : m0) * 1024) + lane;
#pragma unroll
            for (int q = 0; q < 4; ++q) { const f32x4 g4 = *(const f32x4*)(F.final_g() + 4 * lane + 256 * q); o[64 * q] = v[r][q] * rstd * g4; } }
    }
}

namespace pg8 {
constexpr int MPROMPT = 16384;
struct EpiResid {
    static constexpr bool PERM = true, AFTER_DRAIN = false, PREFETCH = true;
    const Frame& F; int l; bool hasnext;
    __device__ __forceinline__ void prefetch(const Unit& u, int i, int wid, int wr, int wc, int lane) const {
        const float* xin = (l == 0) ? F.x_prompt() : F.XL(l - 1);
        const float* base = xin + (size_t)(u.pm * BM + wr * 64 + (i >> 2) * HALF + 16 * (i & 3)) * 1024 + u.pn * BM + wc * 32;
        const unsigned voff = (unsigned)(lane >> 2) * 4096u + (unsigned)((lane >> 1) & 1) * 512u + (unsigned)(lane & 1) * 64u;
        const unsigned dst = (unsigned)(size_t)(F.lds + RING_BYTES) + (unsigned)wid * 1024u; unsigned keep;
        asm volatile("s_mov_b32 %0, m0\n\ts_mov_b32 m0, %3\n\ts_nop 0\n\tglobal_load_lds_dwordx4 %1, %2\n\ts_mov_b32 m0, %0" : "=&s"(keep) : "v"(voff), "s"(base), "s"(dst) : "memory");
    }
    __device__ __forceinline__ void operator()(const f32x4 (&acc)[2][2][4][2], const Unit& u, int wr, int wc, int fr, int fq) const {
        const float* xin = (l == 0) ? F.x_prompt() : F.XL(l - 1); float* xout = F.XL(l); const float* gate = F.mod() + (size_t)l * 36 * 3072 + 2048;
        bf16_t* hn = hasnext ? F.HN() : nullptr; const float* gnext = F.norm_g() + (l + 1) * 1024; const float* scnext = F.mod() + (size_t)(l + 1) * 36 * 3072 + 1024; float* rss = F.RSS(hasnext ? l + 1 : 0);
        const int row0 = u.pm * BM + wr * 64 + fr, col0 = u.pn * BM + wc * 32 + 8 * fq;
        const int mr = row0 >> 12;
        float ss[2][4];
#pragma unroll
        for (int ai = 0; ai < 2; ++ai)
#pragma unroll
            for (int m = 0; m < 4; ++m) ss[ai][m] = 0.f;
#pragma unroll
        for (int bj = 0; bj < 2; ++bj) { const int c = col0 + bj * HALF;
            const f32x4 g0 = *(const f32x4*)(gate + (size_t)mr * 3072 + c), g1 = *(const f32x4*)(gate + (size_t)mr * 3072 + c + 4);
            f32x4 m0 = g0, m1 = g1;
            if (hn) { const f32x4 a0 = *(const f32x4*)(gnext + c), a1 = *(const f32x4*)(gnext + c + 4), s0 = *(const f32x4*)(scnext + (size_t)mr * 3072 + c), s1 = *(const f32x4*)(scnext + (size_t)mr * 3072 + c + 4);
                m0 = a0 * (s0 + 1.f); m1 = a1 * (s1 + 1.f); }
#pragma unroll
            for (int ai = 0; ai < 2; ++ai)
#pragma unroll
              for (int mh = 0; mh < 2; ++mh) {
                f32x4 xo[2][2];
#pragma unroll
                for (int mm = 0; mm < 2; ++mm) { const size_t ro = (size_t)(row0 + ai * HALF + (2 * mh + mm) * 16) * 1024 + c; xo[mm][0] = *(const f32x4*)(xin + ro); xo[mm][1] = *(const f32x4*)(xin + ro + 4); }
#pragma unroll
                for (int mm = 0; mm < 2; ++mm) asm volatile("" : "+v"(xo[mm][0]), "+v"(xo[mm][1]));
#pragma unroll
                for (int mm = 0; mm < 2; ++mm) { const int m = 2 * mh + mm; const size_t ro = (size_t)(row0 + ai * HALF + m * 16) * 1024 + c;
                    const f32x4 x0 = xo[mm][0] + g0 * acc[ai][bj][m][0], x1 = xo[mm][1] + g1 * acc[ai][bj][m][1];
                    *(f32x4*)(xout + ro) = x0; *(f32x4*)(xout + ro + 4) = x1;
                    if (hn) { ss[ai][m] += (x0[0] * x0[0] + x0[1] * x0[1]) + (x0[2] * x0[2] + x0[3] * x0[3]) + (x1[0] * x1[0] + x1[1] * x1[1]) + (x1[2] * x1[2] + x1[3] * x1[3]);
                        const f32x4 h0 = x0 * m0, h1 = x1 * m1;
                        u32x4 w; w.x = cvt_pk_bf16(h0[0], h0[1]); w.y = cvt_pk_bf16(h0[2], h0[3]); w.z = cvt_pk_bf16(h1[0], h1[1]); w.w = cvt_pk_bf16(h1[2], h1[3]);
                        *(u32x4*)(hn + ro) = w; } } } }
        if (hn) {
#pragma unroll
            for (int ai = 0; ai < 2; ++ai)
#pragma unroll
                for (int m = 0; m < 4; ++m) { float v = ss[ai][m]; const int ln = fr + 16 * fq;
                    v += __builtin_bit_cast(float, __builtin_amdgcn_ds_bpermute((ln ^ 16) << 2, __builtin_bit_cast(int, v))); v += __builtin_bit_cast(float, __builtin_amdgcn_ds_bpermute((ln ^ 32) << 2, __builtin_bit_cast(int, v)));
                    if (fq == 0) atomicAdd(rss + row0 + ai * HALF + m * 16, v); } }
    }
};
struct EpiFinal {
    static constexpr bool PERM = true, AFTER_DRAIN = true, PREFETCH = true;
    const Frame& F; int l;
    __device__ __forceinline__ void prefetch(const Unit& u, int i, int wid, int wr, int wc, int lane) const {
        const float* xin = F.XL(l - 1);
        const float* base = xin + (size_t)(u.pm * BM + wr * 64 + (i >> 2) * HALF + 16 * (i & 3)) * 1024 + u.pn * BM + wc * 32;
        const unsigned voff = (unsigned)(lane >> 2) * 4096u + (unsigned)((lane >> 1) & 1) * 512u + (unsigned)(lane & 1) * 64u;
        const unsigned dst = (unsigned)(size_t)(F.lds + RING_BYTES) + (unsigned)wid * 1024u; unsigned keep;
        asm volatile("s_mov_b32 %0, m0\n\ts_mov_b32 m0, %3\n\ts_nop 0\n\tglobal_load_lds_dwordx4 %1, %2\n\ts_mov_b32 m0, %0" : "=&s"(keep) : "v"(voff), "s"(base), "s"(dst) : "memory");
    }
    template <class L> __device__ __forceinline__ void fused(f32x4 (&acc)[2][2][4][2], const Unit& u, int wr, int wc, int fr, int fq, L lds, int wid, int lane) const {
        const LAS unsigned char* park = (const LAS unsigned char*)lds + (unsigned)(wid * 64 + lane) * 16u;
        const float* xin = F.XL(l - 1); const float* gate = F.mod() + (size_t)l * 36 * 3072 + 2048; float* rss = F.RSS(0);
        int row0 = u.pm * BM + wr * 64 + fr, col0 = u.pn * BM + wc * 32 + 8 * fq;
        asm volatile("" : "+v"(row0), "+v"(col0));
        const int mr = row0 >> 12;
        float ss[2][4];
#pragma unroll
        for (int ai = 0; ai < 2; ++ai)
#pragma unroll
            for (int m = 0; m < 4; ++m) ss[ai][m] = 0.f;
#pragma unroll
        for (int bj = 0; bj < 2; ++bj) { const int c = col0 + bj * HALF;
            const f32x4 g0 = *(const f32x4*)(gate + (size_t)mr * 3072 + c), g1 = *(const f32x4*)(gate + (size_t)mr * 3072 + c + 4);
#pragma unroll
            for (int ai = 0; ai < 2; ++ai)
#pragma unroll
              for (int mh = 0; mh < 2; ++mh) {
                f32x4 xo[2][2];
#pragma unroll
                for (int mm = 0; mm < 2; ++mm) { const size_t ro = (size_t)(row0 + ai * HALF + (2 * mh + mm) * 16) * 1024 + c; xo[mm][0] = *(const f32x4*)(xin + ro); xo[mm][1] = *(const f32x4*)(xin + ro + 4); }
#pragma unroll
                for (int mm = 0; mm < 2; ++mm) asm volatile("" : "+v"(xo[mm][0]), "+v"(xo[mm][1]));
#pragma unroll
                for (int mm = 0; mm < 2; ++mm) { const int m = 2 * mh + mm;
                    const f32x4 x0 = xo[mm][0] + g0 * acc[ai][bj][m][0], x1 = xo[mm][1] + g1 * acc[ai][bj][m][1];
                    if (bj == 0) { acc[ai][0][m][0] = x0; acc[ai][0][m][1] = x1; }
                    else { *(LAS f32x4*)(park + ((ai * 4 + m) * 2 + 0) * 8192) = x0; *(LAS f32x4*)(park + ((ai * 4 + m) * 2 + 1) * 8192) = x1; }
                    ss[ai][m] += (x0[0] * x0[0] + x0[1] * x0[1]) + (x0[2] * x0[2] + x0[3] * x0[3]) + (x1[0] * x1[0] + x1[1] * x1[1]) + (x1[2] * x1[2] + x1[3] * x1[3]); }
                asm volatile("" ::: "memory"); } }
        const int ln = fr + 16 * fq; float got = 0.f;
#pragma unroll
        for (int ai = 0; ai < 2; ++ai)
#pragma unroll
            for (int m = 0; m < 4; ++m) { float v = ss[ai][m];
                v += __builtin_bit_cast(float, __builtin_amdgcn_ds_bpermute((ln ^ 16) << 2, __builtin_bit_cast(int, v))); v += __builtin_bit_cast(float, __builtin_amdgcn_ds_bpermute((ln ^ 32) << 2, __builtin_bit_cast(int, v)));
                ss[ai][m] = v; }
        if (fq == 0) { float r[2][4];
#pragma unroll
            for (int ai = 0; ai < 2; ++ai)
#pragma unroll
                for (int m = 0; m < 4; ++m) r[ai][m] = atomicAdd(rss + row0 + ai * HALF + m * 16, ss[ai][m]);
#pragma unroll
            for (int ai = 0; ai < 2; ++ai)
#pragma unroll
                for (int m = 0; m < 4; ++m) asm volatile("" : "+v"(r[ai][m]));
            got = r[0][0]; }
        asm volatile("s_waitcnt vmcnt(0)" : "+v"(got) :: "memory");
        gu32* cnt = F.ctl() + CW_FIN + u.pm * FIN_STRIDE;
        if (ln == 0) __hip_atomic_fetch_add(cnt, 1u, RLX_AGENT);
        for (int it = 0; it < (1 << 20); ++it) { if (__hip_atomic_load(cnt, RLX_AGENT) >= 32u) break; __builtin_amdgcn_s_sleep(2); }
        asm volatile("" : "+v"(row0), "+v"(col0));
        float rs[2][4];
#pragma unroll
        for (int ai = 0; ai < 2; ++ai)
#pragma unroll
            for (int m = 0; m < 4; ++m) rs[ai][m] = __hip_atomic_load(rss + row0 + ai * HALF + m * 16, RLX_AGENT);
#pragma unroll
        for (int ai = 0; ai < 2; ++ai)
#pragma unroll
            for (int m = 0; m < 4; ++m) rs[ai][m] = __builtin_amdgcn_rsqf(rs[ai][m] * (1.f / 1024.f) + 1e-6f);
        float* out = F.out(); const float* fg = F.final_g();
#pragma unroll
        for (int bj = 0; bj < 2; ++bj) { const int c = col0 + bj * HALF;
            const f32x4 f0 = *(const f32x4*)(fg + c), f1 = *(const f32x4*)(fg + c + 4);
#pragma unroll
            for (int ai = 0; ai < 2; ++ai)
#pragma unroll
                for (int m = 0; m < 4; ++m) { const size_t ro = (size_t)(row0 + ai * HALF + m * 16) * 1024 + c;
                    f32x4 x0, x1;
                    if (bj == 0) { x0 = acc[ai][0][m][0]; x1 = acc[ai][0][m][1]; }
                    else { x0 = *(const LAS f32x4*)(park + ((ai * 4 + m) * 2 + 0) * 8192); x1 = *(const LAS f32x4*)(park + ((ai * 4 + m) * 2 + 1) * 8192); }
                    *(f32x4*)(out + ro) = x0 * rs[ai][m] * f0; *(f32x4*)(out + ro + 4) = x1 * rs[ai][m] * f1; } }
    }
};
struct EpiXg {
    static constexpr bool PERM = true, AFTER_DRAIN = false, PREFETCH = false;
    const Frame& F; int l; bool fused; int mall;
    __device__ __forceinline__ void operator()(const f32x4 (&acc)[2][2][4][2], const Unit& u, int wr, int wc, int fr, int fq) const {
        bf16_t* O = F.XG(); const float* rss = fused ? F.RSS(l) : nullptr; const float* sw = F.SW(l);
        const int row0 = u.pm * BM + wr * 64 + fr, col0 = u.pn * BM + wc * 32 + 8 * fq;
        float rs[2][4];
#pragma unroll
        for (int ai = 0; ai < 2; ++ai)
#pragma unroll
            for (int m = 0; m < 4; ++m) rs[ai][m] = rss ? rss[row0 + ai * HALF + m * 16] : 1024.f;
        f32x4 wsw[2][2];
#pragma unroll
        for (int bj = 0; bj < 2; ++bj) { wsw[bj][0] = (f32x4){0.f, 0.f, 0.f, 0.f}; wsw[bj][1] = wsw[bj][0];
            if (rss) { const float* sp = sw + (size_t)(row0 >> 12) * 3072 + col0 + bj * HALF; wsw[bj][0] = *(const f32x4*)sp; wsw[bj][1] = *(const f32x4*)(sp + 4); } }
#pragma unroll
        for (int ai = 0; ai < 2; ++ai)
#pragma unroll
            for (int m = 0; m < 4; ++m) rs[ai][m] = rss ? __builtin_amdgcn_rsqf(rs[ai][m] * (1.f / 1024.f) + 1e-6f) : 1.f;
#pragma unroll
        for (int bj = 0; bj < 2; ++bj) { const int c = col0 + bj * HALF, nb2 = c / 96, cin = c - nb2 * 96;
            bf16_t* cb = O + ((size_t)nb2 * mall) * 96 + cin;
            const f32x4 w0 = wsw[bj][0], w1 = wsw[bj][1];
#pragma unroll
            for (int ai = 0; ai < 2; ++ai)
#pragma unroll
                for (int m = 0; m < 4; ++m) { const int row = row0 + ai * HALF + m * 16; const f32x4 v0 = acc[ai][bj][m][0] * rs[ai][m] + w0, v1 = acc[ai][bj][m][1] * rs[ai][m] + w1;
                    u32x4 w; w.x = cvt_pk_bf16(v0[0], v0[1]); w.y = cvt_pk_bf16(v0[2], v0[3]); w.z = cvt_pk_bf16(v1[0], v1[1]); w.w = cvt_pk_bf16(v1[2], v1[3]);
                    *(u32x4*)(cb + (size_t)row * 96) = w; } }
    }
};
struct EpiQkv {
    static constexpr bool PERM = true, AFTER_DRAIN = false, PREFETCH = false;
    const Frame& F; int l; int j;
    __device__ __forceinline__ void operator()(const f32x4 (&acc)[2][2][4][2], const Unit& u, int wr, int wc, int fr, int fq) const {
        bf16_t* O = F.XG(); float* out = F.out(); const float* rss = F.RSS(l); const float* sw = F.SW(l);
        const int row0 = u.pm * BM + wr * 64 + fr; const int colt = u.pn * BM;
        const int gp = colt >> 10, g = gp / 3, part = gp - 3 * g;
        const int ld = (gp == 9) ? 4 : 2 * g;
        const bool kv = (gp < 9) && (part >= 1);
        const int W = 128 << (2 * g);
        const size_t offp = (g == 0) ? 17088512u : (g == 1) ? 19185664u : 27574272u;
        const int hd0 = (colt & 1023) + wc * 32 + 8 * fq;
        bf16_t* rbase = O + (size_t)gp * 16777216u + (size_t)(row0 >> 12) * 4194304u;
        float rs[2][4];
#pragma unroll
        for (int ai = 0; ai < 2; ++ai)
#pragma unroll
            for (int m = 0; m < 4; ++m) rs[ai][m] = rss[row0 + ai * HALF + m * 16];
        f32x4 wsw[2][2];
#pragma unroll
        for (int bj = 0; bj < 2; ++bj) { const float* sp = sw + (size_t)(row0 >> 12) * 10240 + colt + wc * 32 + 8 * fq + bj * HALF; wsw[bj][0] = *(const f32x4*)sp; wsw[bj][1] = *(const f32x4*)(sp + 4); }
#pragma unroll
        for (int ai = 0; ai < 2; ++ai)
#pragma unroll
            for (int m = 0; m < 4; ++m) rs[ai][m] = __builtin_amdgcn_rsqf(rs[ai][m] * (1.f / 1024.f) + 1e-6f);
#pragma unroll
        for (int bj = 0; bj < 2; ++bj) { const int hd = hd0 + bj * HALF;
            const f32x4 w0 = wsw[bj][0], w1 = wsw[bj][1];
#pragma unroll
            for (int ai = 0; ai < 2; ++ai)
#pragma unroll
                for (int m = 0; m < 4; ++m) { const int row = row0 + ai * HALF + m * 16; const int t = row & 4095;
                    const int pp = ((t & ((1 << ld) - 1)) << (12 - ld)) | (t >> ld);
                    const f32x4 v0 = acc[ai][bj][m][0] * rs[ai][m] + w0, v1 = acc[ai][bj][m][1] * rs[ai][m] + w1;
                    u32x4 w; w.x = cvt_pk_bf16(v0[0], v0[1]); w.y = cvt_pk_bf16(v0[2], v0[3]); w.z = cvt_pk_bf16(v1[0], v1[1]); w.w = cvt_pk_bf16(v1[2], v1[3]);
                    *(u32x4*)(rbase + ((size_t)((hd >> 6) * 4096 + pp)) * 64 + (hd & 63)) = w;
                    if (kv && t >= 4096 - W) { float* kvp = out + offp + ((size_t)((j * 4 + (row >> 12)) * W + (t - (4096 - W))) * 2 + (part - 1)) * 1024 + hd;
                        *(f32x4*)kvp = v0; *(f32x4*)(kvp + 4) = v1; } } }
    }
};
}
constexpr int SC_XP = 0, SC_GB_P = 53888, SC_GB_S = 73728, SC_W = 107136, SC_WP = 208, SC_AGG = 147072, SC_CIN = 153216, SC_COLC = 153600, SC_PAIR = 156672;
__device__ __forceinline__ size_t xb_off(int nb2, int row) { return ((size_t)nb2 * MALL + row) * 96; }

__device__ __forceinline__ float sp8_of(float lam) { const float x = __builtin_amdgcn_exp2f(-LOG2E * lam);
    const float ser = x * (1.f + x * (-0.5f + x * (0.33333334f + x * (-0.25f + x * (0.2f + x * (-0.16666667f))))));
    const float l1p = (x < 0.125f) ? ser : LN2 * __log2f(1.f + x);
    return -8.f * LOG2E * l1p; }
__device__ __forceinline__ void scan_stage_colc(Frame& F, int j, int nb, int tid) {
    const int col0 = nb * 96;
    float cc8 = 0.f, cc8b = 0.f;
    { const int e = tid, row = e / 96, c = e - row * 96, gcol = j * 1536 + col0 + c;
      if (e < 480) cc8 = (row < 4) ? F.lru_conv_w()[((size_t)j * 4 + row) * 1536 + col0 + c] : F.lru_conv_b()[gcol];
      if (e < 288) { const int r2 = e / 96, c2 = e - r2 * 96, g2 = j * 1536 + col0 + c2;
          cc8b = (r2 == 0) ? F.lru_ba()[g2] : (r2 == 1) ? F.lru_bx()[g2] : sp8_of(F.lru_lambda()[g2]); } }
    if (tid < 480) ((LAS float*)(F.lds + SC_COLC))[tid] = cc8;
    if (tid < 288) ((LAS float*)(F.lds + SC_COLC))[480 + tid] = cc8b;
}

__device__ __forceinline__ void carry_publish(unsigned long long* g, float v) { __hip_atomic_store(g, (1ull << 32) | (unsigned long long)__builtin_bit_cast(unsigned, v), __ATOMIC_RELAXED, __HIP_MEMORY_SCOPE_AGENT); }
__device__ __forceinline__ float carry_wait(unsigned long long* g) { unsigned long long x; unsigned spins = 0;
    for (;;) { x = __hip_atomic_load(g, __ATOMIC_RELAXED, __HIP_MEMORY_SCOPE_AGENT); if ((unsigned)(x >> 32) == 1u || ++spins > (1u << 22)) break; __builtin_amdgcn_s_sleep(1); }
    return __builtin_bit_cast(float, (unsigned)x); }
__device__ __forceinline__ void scan_xp_dma(Frame& F, int nb, int pm, int w, int lane) {
    const bf16* xt = F.XG() + xb_off(nb, pm * 256) - 288;
#pragma unroll
    for (int i = 0; i < 7; ++i) { const int p = w * 7 + i; if (p < 49) glds16(xt + (size_t)(p * 64 + lane) * 8, (unsigned)(size_t)(F.lds + SC_XP + p * 1024)); }
}
__device__ __forceinline__ void scan_core(Frame& F, int j, int pm, int nb, int tid_in, bool samp, int sb0, int next_pm) {
    LAS unsigned char* lds = F.lds;
    int tid_ = tid_in; asm volatile("" : "+v"(tid_));
    const int tid = tid_, lane = tid & 63, w = __builtin_amdgcn_readfirstlane(tid >> 6), fr = lane & 15, fq = lane >> 4;
    constexpr int SC_GB = SC_GB_P, GBP = 192, XPI = 192;
    const int col0 = nb * 96, b = pm >> 4, ci = pm & 15;
    const bool active = !samp || w < 4;
    {
        if (!samp) { if (ci == 15 && tid < 288) { const int q = tid / 96, c = tid - q * 96;
            F.out()[OFF_PCONV + ((size_t)(j * 4 + b) * 3 + q) * 1536 + col0 + c] = bf2f(*(const LAS bf16*)(lds + SC_XP + (256 + q) * XPI + c * 2)); } }
        else { for (int e = tid; e < 16 * 288; e += 512) { const int lb = e / 288, rem = e - lb * 288, q = rem / 96, c = rem - q * 96;
            F.out()[OFF_SCONV + ((size_t)(j * 32 + sb0 + lb) * 3 + q) * 1536 + col0 + c] = bf2f(*(const LAS bf16*)(lds + SC_XP + (lb * 11 + 8 + q) * XPI + c * 2)); } }
    }
    if (active) {
    const LAS float* colc = (const LAS float*)(lds + SC_COLC);
    bf16x8 Af[2][3];
#pragma unroll
    for (int ks = 0; ks < 3; ++ks) {
        const int c8 = 32 * ks + 8 * fq;
        f32x4 cw[4][2], cb[2];
#pragma unroll
        for (int t = 0; t < 4; ++t) { cw[t][0] = *(const LAS f32x4*)(colc + t * 96 + c8); cw[t][1] = *(const LAS f32x4*)(colc + t * 96 + c8 + 4); }
        cb[0] = *(const LAS f32x4*)(colc + 4 * 96 + c8); cb[1] = *(const LAS f32x4*)(colc + 4 * 96 + c8 + 4);
#pragma unroll
        for (int m = 0; m < 2; ++m) { const int row = 32 * w + 16 * m + fr; const int rb = samp ? (row >> 3) * 11 + (row & 7) : row;
            f32x4 a0 = cb[0], a1 = cb[1];
#pragma unroll
            for (int t = 0; t < 4; ++t) { const v4u xv = *(const LAS v4u*)(lds + SC_XP + (rb + t) * XPI + c8 * 2);
                a0.x += cw[t][0].x * bflo(xv.x); a0.y += cw[t][0].y * bfhi(xv.x); a0.z += cw[t][0].z * bflo(xv.y); a0.w += cw[t][0].w * bfhi(xv.y);
                a1.x += cw[t][1].x * bflo(xv.z); a1.y += cw[t][1].y * bfhi(xv.z); a1.z += cw[t][1].z * bflo(xv.w); a1.w += cw[t][1].w * bfhi(xv.w); }
            v4u pk; pk.x = pk2(a0.x, a0.y); pk.y = pk2(a0.z, a0.w); pk.z = pk2(a1.x, a1.y); pk.w = pk2(a1.z, a1.w);
            Af[m][ks] = __builtin_bit_cast(bf16x8, pk); }
    }
    bf16x8 sel0, sel1;
    { const int e0 = (fq == 0 && fr < 8) ? fr : (fq == 1 && fr >= 8) ? fr - 8 : -1, e1 = (fq == 2 && fr < 8) ? fr : (fq == 3 && fr >= 8) ? fr - 8 : -1;
#pragma unroll
      for (int e = 0; e < 8; ++e) { sel0[e] = (e == e0) ? (short)0x3F80 : (short)0; sel1[e] = (e == e1) ? (short)0x3F80 : (short)0; } }
    LAS f32x2* aggL = (LAS f32x2*)(lds + SC_AGG);
#pragma unroll
    for (int half = 0; half < 2; ++half) {
    f32x4 av[2][3], uv[2][3]; float Pq[2][3], Hq[2][3];
#pragma unroll
    for (int n3 = 0; n3 < 3; ++n3) {
        const int nt = 3 * half + n3;
        const int col = 16 * nt + fr;
        bf16x8 Ba[3], Bx[3];
#pragma unroll
        for (int ks = 0; ks < 3; ++ks) {
            Ba[ks] = *(const LAS bf16x8*)(lds + SC_W + col * SC_WP + 64 * ks + 16 * fq); Bx[ks] = *(const LAS bf16x8*)(lds + SC_W + (96 + col) * SC_WP + 64 * ks + 16 * fq); }
        const float ba = colc[480 + col], bx = colc[576 + col], sp8 = colc[672 + col];
        float P4[2], H4[2];
#pragma unroll
        for (int m = 0; m < 2; ++m) {
            f32x4 rp = (f32x4){0.f, 0.f, 0.f, 0.f}, ip = rp, xc = rp;
#pragma unroll
            for (int ks = 0; ks < 3; ++ks) { rp = __builtin_amdgcn_mfma_f32_16x16x32_bf16(Af[m][ks], Ba[ks], rp, 0, 0, 0); ip = __builtin_amdgcn_mfma_f32_16x16x32_bf16(Af[m][ks], Bx[ks], ip, 0, 0, 0); }
            xc = __builtin_amdgcn_mfma_f32_16x16x32_bf16(Af[m][nt >> 1], (nt & 1) ? sel1 : sel0, xc, 0, 0, 0);
            f32x4 a4, u4;
#pragma unroll
            for (int e = 0; e < 4; ++e) { const float rr = sigmoid_f(rp[e] + ba), ig = sigmoid_f(ip[e] + bx), la = sp8 * rr;
                const float a = __builtin_amdgcn_exp2f(la); a4[e] = a; u4[e] = __builtin_amdgcn_sqrtf(fmaxf(1.f - a * a, 0.f)) * ig * xc[e]; }
            av[m][n3] = a4; uv[m][n3] = u4;
            P4[m] = (a4[0] * a4[1]) * (a4[2] * a4[3]);
            H4[m] = ((u4[0] * a4[1] + u4[1]) * a4[2] + u4[2]) * a4[3] + u4[3];
        }
        if (!samp) {
            float Pt[2], Ht[2];
#pragma unroll
            for (int m = 0; m < 2; ++m) {
                float P = P4[m], H = H4[m];
                { const float Pn = shup(P, lane, 16), Hn = shup(H, lane, 16); if (fq >= 1) { H = P * Hn + H; P = P * Pn; } }
                { const float Pn = shup(P, lane, 32), Hn = shup(H, lane, 32); if (fq >= 2) { H = P * Hn + H; P = P * Pn; } }
                const float Pe = shup(P, lane, 16), He = shup(H, lane, 16);
                Pq[m][n3] = (fq == 0) ? 1.f : Pe; Hq[m][n3] = (fq == 0) ? 0.f : He;
                Pt[m] = shl(P, 48 + fr); Ht[m] = shl(H, 48 + fr);
            }
            Hq[1][n3] = Pq[1][n3] * Ht[0] + Hq[1][n3]; Pq[1][n3] = Pq[1][n3] * Pt[0];
            if (fq == 0) { f32x2 t; t.x = Pt[0] * Pt[1]; t.y = Pt[1] * Ht[0] + Ht[1]; aggL[w * 96 + col] = t; }
        } else {
#pragma unroll
            for (int m = 0; m < 2; ++m) { const float Pn = shup(P4[m], lane, 16), Hn = shup(H4[m], lane, 16);
                Pq[m][n3] = (fq & 1) ? Pn : 1.f; Hq[m][n3] = (fq & 1) ? Hn : 0.f; }
        }
    }
    if (!samp) {
        if (half == 0) asm volatile("s_waitcnt vmcnt(0)" ::: "memory");
        __syncthreads();
        if (half == 0 && next_pm >= 0) scan_xp_dma(F, nb, next_pm, w, lane);
        unsigned long long* ag = F.carry() + (((size_t)(j * 64 + pm)) * 1536 + col0 + 48 * half) * 2;
        float Pu = 1.f, Hu = 0.f;
        if (tid < 48) {
#pragma unroll
            for (int ww = 0; ww < 8; ++ww) { const f32x2 t = aggL[ww * 96 + 48 * half + tid]; Hu = t.x * Hu + t.y; Pu = t.x * Pu; }
            carry_publish(ag + 2 * tid, Pu); carry_publish(ag + 2 * tid + 1, Hu); }
        if (tid < 384) { const int c = tid % 48, grp = tid / 48, c0 = 2 * grp; float P = 1.f, H = 0.f;
            unsigned long long* pg = F.carry() + (((size_t)(j * 64 + pm - ci + c0)) * 1536 + col0 + 48 * half + c) * 2;
            if (c0 < ci) {
                const bool two = c0 + 1 < ci; unsigned long long x0, x1, x2, x3; unsigned spins = 0;
                for (;;) { x0 = __hip_atomic_load(pg, __ATOMIC_RELAXED, __HIP_MEMORY_SCOPE_AGENT); x1 = __hip_atomic_load(pg + 1, __ATOMIC_RELAXED, __HIP_MEMORY_SCOPE_AGENT);
                    x2 = two ? __hip_atomic_load(pg + 3072, __ATOMIC_RELAXED, __HIP_MEMORY_SCOPE_AGENT) : (1ull << 32); x3 = two ? __hip_atomic_load(pg + 3073, __ATOMIC_RELAXED, __HIP_MEMORY_SCOPE_AGENT) : (1ull << 32);
                    if ((((unsigned)(x0 >> 32) & (unsigned)(x1 >> 32) & (unsigned)(x2 >> 32) & (unsigned)(x3 >> 32)) == 1u) || ++spins > (1u << 22)) break; __builtin_amdgcn_s_sleep(1); }
                P = __builtin_bit_cast(float, (unsigned)x0); H = __builtin_bit_cast(float, (unsigned)x1);
                if (two) { const float p1 = __builtin_bit_cast(float, (unsigned)x2), h1 = __builtin_bit_cast(float, (unsigned)x3); H = p1 * H + h1; P = p1 * P; } }
            f32x2 t; t.x = P; t.y = H; ((LAS f32x2*)(lds + SC_PAIR))[grp * 48 + c] = t; }
        __syncthreads();
        if (tid < 48) { float c = 0.f;
#pragma unroll
            for (int grp = 0; grp < 8; ++grp) { const f32x2 t = ((const LAS f32x2*)(lds + SC_PAIR))[grp * 48 + tid]; c = t.x * c + t.y; }
            ((LAS float*)(lds + SC_CIN))[48 * half + tid] = c;
            if (ci == 15) F.out()[OFF_PH + ((size_t)j * 4 + b) * 1536 + col0 + 48 * half + tid] = Pu * c + Hu; }
        __syncthreads();
    }
    {
#pragma unroll
        for (int n3 = 0; n3 < 3; ++n3) {
            const int nt = 3 * half + n3;
            const int col = 16 * nt + fr;
            float cwv = 0.f;
            if (!samp) { cwv = ((const LAS float*)(lds + SC_CIN))[col];
#pragma unroll
                for (int ww = 0; ww < 7; ++ww) if (ww < w) { const f32x2 t = aggL[ww * 96 + col]; cwv = t.x * cwv + t.y; } }
#pragma unroll
            for (int m = 0; m < 2; ++m) {
                const int sb = sb0 + 4 * w + 2 * m + (fq >> 1);
                float c = cwv; if (samp) c = F.state_h()[((size_t)j * 32 + sb) * 1536 + col0 + col];
                float h = Pq[m][n3] * c + Hq[m][n3];
#pragma unroll
                for (int e = 0; e < 4; ++e) { h = av[m][n3][e] * h + uv[m][n3][e];
                    const int row = 32 * w + 16 * m + 4 * fq + e;
                    const float gbv = bf2f(*(const LAS bf16*)(lds + SC_GB + row * GBP + col * 2));
                    *(LAS bf16*)(lds + SC_GB + row * GBP + col * 2) = (bf16)f2bf(h * silu_f(gbv)); }
                if (samp && (fq & 1)) F.out()[OFF_SH + ((size_t)j * 32 + sb) * 1536 + col0 + col] = h;
            }
        }
    }
    }
    }
    {
        __syncthreads();
        const int nch = samp ? 1536 : 3072; const size_t yrow0 = samp ? (size_t)MP + 8 * sb0 : (size_t)pm * 256;
#pragma unroll
        for (int i = 0; i < 6; ++i) { const int ch = tid + 512 * i, r = ch / 12, cc = ch - r * 12;
            if (ch < nch) *(GAS v4u*)(F.Y() + (yrow0 + r) * 1536 + col0 + cc * 8) = *(const LAS v4u*)(lds + SC_GB + r * GBP + cc * 16); }
    }
}

__device__ __forceinline__ void scan_phase(Frame& F, int j) {
    LAS unsigned char* lds = F.lds;
    int tid_ = F.tid; asm volatile("" : "+v"(tid_));
    const int tid = tid_, lane = tid & 63, w = __builtin_amdgcn_readfirstlane(tid >> 6), fr = lane & 15, fq = lane >> 4;
    const bf16* XB = F.XG();
    int o = F.vcu, nb_staged = -1;
#define SCAN_PM(O) ((((O) >> 4) & 3) * 16 + ((O) >> 6))
    __syncthreads();
    if (o < 1024) scan_xp_dma(F, o & 15, SCAN_PM(o), w, lane);
    for (; o < 1056; o += F.G) {
        const bool samp = o >= 1024; const int nb = o & 15, pm = samp ? 64 : SCAN_PM(o), sb0 = samp ? ((o >> 4) & 1) * 16 : 0;
        if (nb != nb_staged) {
            __syncthreads();
            scan_stage_colc(F, j, nb, tid);
            v4u wr5[5];
#pragma unroll
            for (int i = 0; i < 5; ++i) { const int ch = tid + 512 * i; if (ch < 2304) { const int r = ch / 12, cc = ch - r * 12;
                const bf16* src = (r < 96 ? F.wa_t() : F.wx_t()) + ((size_t)(j * 16 + nb) * 96 + (r < 96 ? r : r - 96)) * 96 + cc * 8; wr5[i] = *(const GAS v4u*)src; } }
#pragma unroll
            for (int i = 0; i < 5; ++i) { const int ch = tid + 512 * i; if (ch < 2304) { const int r = ch / 12, cc = ch - r * 12; *(LAS v4u*)(lds + SC_W + r * SC_WP + cc * 16) = wr5[i]; } }
            nb_staged = nb;
        }
        if (!samp) {
            asm volatile("s_waitcnt vmcnt(0)" ::: "memory");
            if ((pm & 15) == 0 && tid < 36) { v4u z4 = (v4u){0u, 0u, 0u, 0u}; asm volatile("" : "+v"(z4)); *(LAS v4u*)(lds + SC_XP + tid * 16) = z4; }
        } else {
#pragma unroll 1
            for (int i = 0; i < 5; ++i) { const int ch = tid + 512 * i; if (ch < 16 * 11 * 12) { const int lr = ch / 12, cc = ch - lr * 12, lb = lr / 11, q = lr - lb * 11, sb = sb0 + lb;
                v4u val;
                if (q < 3) { const float* sp = F.state_conv() + ((size_t)((j * 32 + sb) * 3 + q)) * 1536 + nb * 96 + cc * 8; const f32x4 a = *(const f32x4*)sp, c = *(const f32x4*)(sp + 4);
                    val.x = pk2(a.x, a.y); val.y = pk2(a.z, a.w); val.z = pk2(c.x, c.y); val.w = pk2(c.z, c.w); }
                else val = *(const GAS v4u*)(XB + xb_off(nb, MP + sb * 8 + q - 3) + cc * 8);
                *(LAS v4u*)(lds + SC_XP + lr * 192 + cc * 16) = val; } }
        }
        __syncthreads();
        { const bf16* gt = XB + xb_off(16 + nb, samp ? MP + 8 * sb0 : pm * 256);
          const int npw = samp ? 3 : 6;
#pragma unroll
          for (int i = 0; i < 6; ++i) if (i < npw) glds16(gt + (size_t)((w * npw + i) * 64 + lane) * 8, (unsigned)(size_t)(lds + SC_GB_P + (w * npw + i) * 1024)); }
        if (samp) { asm volatile("s_waitcnt vmcnt(0)" ::: "memory"); __syncthreads(); }
        const int on = o + F.G;
        scan_core(F, j, pm, nb, tid, samp, sb0, (on < 1024 && (on & 15) == nb) ? SCAN_PM(on) : -1);
        if (on < 1024 && (on & 15) != nb) { __syncthreads(); scan_xp_dma(F, on & 15, SCAN_PM(on), w, lane); }
    }
#undef SCAN_PM
}

__device__ __forceinline__ s16x4 vtr(const LAS unsigned char* p) { typedef short v4i16_t __attribute__((ext_vector_type(4)));
    return __builtin_bit_cast(s16x4, __builtin_amdgcn_ds_read_tr16_b64_v4i16((LAS v4i16_t*)p)); }

constexpr int ATT_SLOT = 65536;
struct AttnPre { bf16x8 q0, q1; v2u po[4]; float plse; v2u gt[4]; };

__device__ __forceinline__ size_t qb_off(int gp, int b, int h, int pp) { return (size_t)gp * 16777216u + ((size_t)((b * 16 + h) * 4096 + pp)) * 64; }
__device__ __forceinline__ void attn_issue(Frame& F, int G, int u, int slot, AttnPre& P, int tid, int w, int fr, int fq) {
    const int ld = 2 * G, DIL = 1 << ld, NCH = 32 >> ld, L = 4096 >> ld;
    const int b = u >> 9, h = (u >> 5) & 15, q32 = u & 31, c = q32 & (NCH - 1), r = q32 >> (5 - ld);
    const int lane = tid & 63;
    const bf16* kt = F.XG() + qb_off(3 * G + 1, b, h, r * L + 128 * c - 128);
#pragma unroll
    for (int i = 0; i < 4; ++i) {
        const int row = w * 32 + i * 8 + (lane >> 3), s = lane & 7, ch = s ^ (row & 7);
        const bf16* kp = kt + row * 64 + ch * 8;
        const unsigned dst = (unsigned)(size_t)(F.lds + slot * ATT_SLOT + (w * 32 + i * 8) * 128);
        glds16(kp, dst); glds16(kp + 16777216, dst + 32768u);
    }
    const int pq = r * L + 128 * c + 16 * w + fr;
    const bf16* qp = F.XG() + qb_off(3 * G, b, h, pq) + 8 * fq;
    P.q0 = *(const bf16x8*)qp; P.q1 = *(const bf16x8*)(qp + 32);
    const int tq = (128 * c + 16 * w + fr) * DIL + r;
    if (G > 0) { const bf16* op = (const bf16*)F.OACC() + ((size_t)((b * 16 + h) * 4096 + tq)) * 64 + 4 * fq;
#pragma unroll
        for (int nt = 0; nt < 4; ++nt) P.po[nt] = *(const GAS v2u*)(op + 16 * nt);
        P.plse = F.lse()[(size_t)(b * 16 + h) * 4096 + tq]; }
    if (G == 2) { const bf16* gp = F.XG() + qb_off(9, b, h, pq) + 4 * fq;
#pragma unroll
        for (int nt = 0; nt < 4; ++nt) P.gt[nt] = *(const GAS v2u*)(gp + 16 * nt); }
}
__device__ __forceinline__ void attn_pin(AttnPre& P) {
    asm volatile("" : "+v"(P.q0), "+v"(P.q1));
#pragma unroll
    for (int nt = 0; nt < 4; ++nt) asm volatile("" : "+v"(P.po[nt]), "+v"(P.gt[nt]));
    asm volatile("" : "+v"(P.plse));
}

__device__ __forceinline__ void attn_compute(Frame& F, int G, int u, int slot, const AttnPre& P, int w, int fr_, int fq_) {
    const int ld = 2 * G, DIL = 1 << ld, NCH = 32 >> ld;
    int fr = fr_, fq = fq_; asm volatile("" : "+v"(fr), "+v"(fq));
    const int lane = fr + 16 * fq;
    const int b = u >> 9, h = (u >> 5) & 15, q32 = u & 31, c = q32 & (NCH - 1), r = q32 >> (5 - ld);
    const LAS unsigned char* kb = F.lds + slot * ATT_SLOT + (16 * w + fr) * 128;
    const LAS unsigned char* kb0 = kb + ((fq ^ (fr & 7)) << 4); const LAS unsigned char* kb1 = kb + (((4 + fq) ^ (fr & 7)) << 4);
    f32x4 st[9];
    { bf16x8 kf[9][2];
#pragma unroll
      for (int T = 0; T < 9; ++T) { kf[T][0] = *(const LAS bf16x8*)(kb0 + T * 2048); kf[T][1] = *(const LAS bf16x8*)(kb1 + T * 2048); }
#pragma unroll
      for (int T = 0; T < 9; ++T) { f32x4 s = (f32x4){0.f, 0.f, 0.f, 0.f};
        s = __builtin_amdgcn_mfma_f32_16x16x32_bf16(kf[T][0], P.q0, s, 0, 0, 0); s = __builtin_amdgcn_mfma_f32_16x16x32_bf16(kf[T][1], P.q1, s, 0, 0, 0); st[T] = s; } }
    const float slope = __builtin_amdgcn_exp2f(-0.5f * (float)(h + 1));
    const float c1 = 0.125f * LOG2E, c2 = slope * (float)DIL * LOG2E;
    const float d0 = (float)(fr - 4 * fq + 128) * c2;
    float mx = -1e30f;
#pragma unroll
    for (int T = 0; T < 9; ++T)
#pragma unroll
        for (int e = 0; e < 4; ++e) { float s2 = st[T][e] * c1 - (d0 - c2 * (float)(16 * T + e));
            if (T == 0) s2 = (4 * fq + e >= fr) ? s2 : -1e30f;
            if (T == 8) s2 = (4 * fq + e <= fr) ? s2 : -1e30f;
            st[T][e] = s2; }
    if (c == 0) {
        const int thr = 128 - 16 * w - 4 * fq;
#pragma unroll
        for (int T = 0; T < 9; ++T)
#pragma unroll
            for (int e = 0; e < 4; ++e) st[T][e] = (16 * T + e >= thr) ? st[T][e] : -1e30f;
    }
#pragma unroll
    for (int T = 0; T < 9; ++T) mx = fmaxf(mx, fmaxf(fmaxf(st[T][0], st[T][1]), fmaxf(st[T][2], st[T][3])));
    mx = fmaxf(mx, shx(mx, lane, 16)); mx = fmaxf(mx, shx(mx, lane, 32));
    float ls = 0.f;
#pragma unroll
    for (int T = 0; T < 9; ++T)
#pragma unroll
        for (int e = 0; e < 4; ++e) { const float p = __builtin_amdgcn_exp2f(st[T][e] - mx); ls += p; st[T][e] = p; }
    ls += shx(ls, lane, 16); ls += shx(ls, lane, 32);
    f32x4 o[4];
#pragma unroll
    for (int nt = 0; nt < 4; ++nt) o[nt] = (f32x4){0.f, 0.f, 0.f, 0.f};
    const int sw = 4 * (fq & 1) + (fr >> 2);
    const LAS unsigned char* vrow = F.lds + slot * ATT_SLOT + 32768 + (16 * w + 4 * fq + (fr >> 2)) * 128 + (fr & 1) * 8;
    const LAS unsigned char* vbs[4];
#pragma unroll
    for (int nt = 0; nt < 4; ++nt) vbs[nt] = vrow + (((2 * nt + ((fr >> 1) & 1)) ^ sw) << 4);
    s16x4 vl[5][4], vh[4][4];
#pragma unroll
    for (int kk = 0; kk < 5; ++kk)
#pragma unroll
        for (int nt = 0; nt < 4; ++nt) { vl[kk][nt] = vtr(vbs[nt] + kk * 4096); if (kk < 4) vh[kk][nt] = vtr(vbs[nt] + kk * 4096 + 2048); }
#pragma unroll
    for (int kk = 0; kk < 5; ++kk) {
        v4u pk; pk.x = pk2(st[2 * kk][0], st[2 * kk][1]); pk.y = pk2(st[2 * kk][2], st[2 * kk][3]);
        if (kk < 4) { const int t1 = (2 * kk + 1 < 9) ? 2 * kk + 1 : 8; pk.z = pk2(st[t1][0], st[t1][1]); pk.w = pk2(st[t1][2], st[t1][3]); } else { pk.z = 0u; pk.w = 0u; }
        const bf16x8 pf = __builtin_bit_cast(bf16x8, pk);
#pragma unroll
        for (int nt = 0; nt < 4; ++nt) {
            const s16x4 lo = vl[kk][nt], hi = (kk < 4) ? vh[kk < 4 ? kk : 3][nt] : lo;
            bf16x8 vf; vf[0] = lo[0]; vf[1] = lo[1]; vf[2] = lo[2]; vf[3] = lo[3]; vf[4] = hi[0]; vf[5] = hi[1]; vf[6] = hi[2]; vf[7] = hi[3];
            o[nt] = __builtin_amdgcn_mfma_f32_16x16x32_bf16(vf, pf, o[nt], 0, 0, 0); }
    }
    const float inv = __builtin_amdgcn_rcpf(ls);
#pragma unroll
    for (int nt = 0; nt < 4; ++nt) o[nt] = o[nt] * inv;
    float lse = (mx + __log2f(ls)) * LN2;
    const int tq = (128 * c + 16 * w + fr) * DIL + r; const size_t row = (size_t)b * SEQ + tq;
    if (G > 0) { const float lp = P.plse; const float m2 = fmaxf(lp, lse); const float ln = m2 + __logf(__expf(lp - m2) + __expf(lse - m2));
        const float wp = __expf(lp - ln), wc = __expf(lse - ln);
#pragma unroll
        for (int nt = 0; nt < 4; ++nt) { const v2u pv = P.po[nt]; const f32x4 po = (f32x4){bflo(pv.x), bfhi(pv.x), bflo(pv.y), bfhi(pv.y)}; o[nt] = po * wp + o[nt] * wc; }
        lse = ln; }
    if (G == 2) {
#pragma unroll
        for (int nt = 0; nt < 4; ++nt) { const v2u gw = P.gt[nt];
            v2u y; y.x = pk2(o[nt].x * silu_f(bflo(gw.x)), o[nt].y * silu_f(bfhi(gw.x))); y.y = pk2(o[nt].z * silu_f(bflo(gw.y)), o[nt].w * silu_f(bfhi(gw.y)));
            *(GAS v2u*)(F.Y() + row * 1024 + h * 64 + 16 * nt + 4 * fq) = y; }
    } else { bf16* op = (bf16*)F.OACC() + ((size_t)((b * 16 + h) * 4096 + tq)) * 64 + 4 * fq;
#pragma unroll
        for (int nt = 0; nt < 4; ++nt) { v2u pv; pv.x = pk2(o[nt].x, o[nt].y); pv.y = pk2(o[nt].z, o[nt].w); *(GAS v2u*)(op + 16 * nt) = pv; }
        if (fq == 0) F.lse()[(size_t)(b * 16 + h) * 4096 + tq] = lse; }
}

struct BlkList { int sub, ns, sp0, sps, glo, ghi; };
__device__ __forceinline__ int blk_count(const BlkList& L) { return L.sub == 0 ? (L.ghi - L.glo) * L.ns * 4 : L.ns * 8; }
__device__ __forceinline__ void blk_at(const BlkList& L, int i, int& G, int& u) {
    if (L.sub != 0) { const int sp = L.sp0 + (i >> 3) * L.sps; G = 2; u = sp * 8 + (i & 7); return; }
    const int per = L.ns * 4, gi = i / per, r = i - gi * per, sp = L.sp0 + (r >> 2) * L.sps, k = r & 3, bh = sp >> 3, c5 = sp & 7;
    G = L.glo + gi; u = (G == 0) ? bh * 32 + 4 * c5 + k : bh * 32 + c5 + 8 * k;
}
__device__ __forceinline__ void attn_blocks(Frame& F, const BlkList& L) {
    int tid_ = F.tid; asm volatile("" : "+v"(tid_));
    const int tid = tid_, lane = tid & 63, w = __builtin_amdgcn_readfirstlane(tid >> 6), fr = lane & 15, fq = lane >> 4;
    const int n = blk_count(L);
    if (n <= 0) return;
    asm volatile("s_waitcnt vmcnt(0)" ::: "memory");
    __syncthreads();
    AttnPre Pc, Pn;
#pragma unroll
    for (int nt = 0; nt < 4; ++nt) { Pc.po[nt] = (v2u){0u, 0u}; Pc.gt[nt] = (v2u){0u, 0u}; } Pc.plse = 0.f; Pn = Pc;
    int Gc, uc; blk_at(L, 0, Gc, uc);
    attn_issue(F, Gc, uc, 0, Pc, tid, w, fr, fq);
    asm volatile("s_waitcnt vmcnt(0)" ::: "memory"); attn_pin(Pc);
    asm volatile("s_waitcnt lgkmcnt(0)\n\ts_barrier" ::: "memory");
    for (int i = 0; i < n; ++i) {
        const int slot = i & 1;
        int Gn, un; blk_at(L, (i + 1 < n) ? i + 1 : i, Gn, un);
        attn_issue(F, Gn, un, slot ^ 1, Pn, tid, w, fr, fq);
        attn_compute(F, Gc, uc, slot, Pc, w, fr, fq);
        asm volatile("s_waitcnt vmcnt(4)" ::: "memory"); attn_pin(Pn);
        asm volatile("s_waitcnt lgkmcnt(0)\n\ts_barrier" ::: "memory");
        Pc = Pn; Gc = Gn; uc = un;
    }
}

__device__ __forceinline__ void up16(const v4u& a, const v4u& c, float (&x)[16]) {
    x[0] = bflo(a.x); x[1] = bfhi(a.x); x[2] = bflo(a.y); x[3] = bfhi(a.y); x[4] = bflo(a.z); x[5] = bfhi(a.z); x[6] = bflo(a.w); x[7] = bfhi(a.w);
    x[8] = bflo(c.x); x[9] = bfhi(c.x); x[10] = bflo(c.y); x[11] = bfhi(c.y); x[12] = bflo(c.z); x[13] = bfhi(c.z); x[14] = bflo(c.w); x[15] = bfhi(c.w); }
__device__ __forceinline__ void attn_sample_task(Frame& F, int G, int j, int sb, int t, int pair, int hf) {
    const int ld = 2 * G, DIL = 1 << ld, BUF = 128 << ld;
    LAS unsigned char* lds = F.lds;
    int tid_ = F.tid; asm volatile("" : "+v"(tid_));
    const int lane = tid_ & 63, w = __builtin_amdgcn_readfirstlane(tid_ >> 6), h = lane >> 2;
    const float* cache = F.A->in[4 + G];
    const float* cbase = cache + (size_t)(j * 32 + sb) * BUF * 2048 + 16 * lane;
    const bf16* qs = F.QS() + G * 3072 + 16 * lane;
    const int t2 = t + DIL;
    float qa[16], qb[16];
    { const bf16* p = qs + ((size_t)sb * 8 + t) * NQKVG; const v4u a = *(const GAS v4u*)p, c = *(const GAS v4u*)(p + 8); up16(a, c, qa); }
    { const bf16* p = qs + ((size_t)sb * 8 + (pair ? t2 : t)) * NQKVG; const v4u a = *(const GAS v4u*)p, c = *(const GAS v4u*)(p + 8); up16(a, c, qb); }
    const float slope = __builtin_amdgcn_exp2f(-0.5f * (float)(h + 1));
    const float c1 = 0.125f * LOG2E, c2 = slope * (float)DIL * LOG2E;
    float ma = -1e30f, la = 0.f, oa[16], mb = -1e30f, lb = 0.f, ob[16];
#pragma unroll
    for (int e = 0; e < 16; ++e) { oa[e] = 0.f; ob[e] = 0.f; }
    const int nnew = t >> ld;
    { const int s = w - 1;
      if (hf == 0 && s <= nnew && (s >= 0 || pair)) { const bf16* kp = qs + ((size_t)sb * 8 + (t - DIL * s)) * NQKVG + 1024;
        const v4u a = *(const GAS v4u*)kp, c = *(const GAS v4u*)(kp + 8), d = *(const GAS v4u*)(kp + 1024), f = *(const GAS v4u*)(kp + 1032);
        float kx[16], vx[16]; up16(a, c, kx); up16(d, f, vx);
        float da = 0.f, db = 0.f;
#pragma unroll
        for (int e = 0; e < 16; ++e) { da += qa[e] * kx[e]; db += qb[e] * kx[e]; }
        da += shx(da, lane, 1); da += shx(da, lane, 2); db += shx(db, lane, 1); db += shx(db, lane, 2);
        if (s >= 0) { ma = da * c1 - c2 * (float)s; la = 1.f;
#pragma unroll
            for (int e = 0; e < 16; ++e) oa[e] = vx[e]; }
        if (pair) { mb = db * c1 - c2 * (float)(s + 1); lb = 1.f;
#pragma unroll
            for (int e = 0; e < 16; ++e) ob[e] = vx[e]; } } }
    const int slo = hf ? 65 : nnew + 1, shi = hf ? 128 : 64;
    for (int s0 = slo + w; s0 <= shi; s0 += 32) {
        f32x4 kk[4][4], vv[4][4];
#pragma unroll
        for (int i = 0; i < 4; ++i) { const int s = s0 + 8 * i, sc = s <= shi ? s : shi; const float* kp = cbase + (size_t)(BUF + t - DIL * sc) * 2048;
#pragma unroll
            for (int e4 = 0; e4 < 4; ++e4) { kk[i][e4] = *(const f32x4*)(kp + 4 * e4); vv[i][e4] = *(const f32x4*)(kp + 1024 + 4 * e4); } }
        float sa[4], sbv[4];
#pragma unroll
        for (int i = 0; i < 4; ++i) { float da = 0.f, db = 0.f;
#pragma unroll
            for (int e4 = 0; e4 < 4; ++e4) { da += qa[4 * e4] * kk[i][e4].x + qa[4 * e4 + 1] * kk[i][e4].y + qa[4 * e4 + 2] * kk[i][e4].z + qa[4 * e4 + 3] * kk[i][e4].w;
                                             db += qb[4 * e4] * kk[i][e4].x + qb[4 * e4 + 1] * kk[i][e4].y + qb[4 * e4 + 2] * kk[i][e4].z + qb[4 * e4 + 3] * kk[i][e4].w; }
            da += shx(da, lane, 1); da += shx(da, lane, 2); db += shx(db, lane, 1); db += shx(db, lane, 2);
            const int s = s0 + 8 * i; sa[i] = (s <= shi) ? da * c1 - c2 * (float)s : -1e30f; sbv[i] = (pair && s <= shi && s < 128) ? db * c1 - c2 * (float)(s + 1) : -1e30f; }
        { const float mn = fmaxf(fmaxf(ma, sa[0]), fmaxf(fmaxf(sa[1], sa[2]), sa[3])), al = __builtin_amdgcn_exp2f(ma - mn);
          float p[4];
#pragma unroll
          for (int i = 0; i < 4; ++i) p[i] = __builtin_amdgcn_exp2f(sa[i] - mn);
          la = la * al + (p[0] + p[1]) + (p[2] + p[3]); ma = mn;
#pragma unroll
          for (int e4 = 0; e4 < 4; ++e4) {
            oa[4 * e4] = oa[4 * e4] * al + (p[0] * vv[0][e4].x + p[1] * vv[1][e4].x) + (p[2] * vv[2][e4].x + p[3] * vv[3][e4].x);
            oa[4 * e4 + 1] = oa[4 * e4 + 1] * al + (p[0] * vv[0][e4].y + p[1] * vv[1][e4].y) + (p[2] * vv[2][e4].y + p[3] * vv[3][e4].y);
            oa[4 * e4 + 2] = oa[4 * e4 + 2] * al + (p[0] * vv[0][e4].z + p[1] * vv[1][e4].z) + (p[2] * vv[2][e4].z + p[3] * vv[3][e4].z);
            oa[4 * e4 + 3] = oa[4 * e4 + 3] * al + (p[0] * vv[0][e4].w + p[1] * vv[1][e4].w) + (p[2] * vv[2][e4].w + p[3] * vv[3][e4].w); } }
        if (pair) { const float mn = fmaxf(fmaxf(mb, sbv[0]), fmaxf(fmaxf(sbv[1], sbv[2]), sbv[3])), al = __builtin_amdgcn_exp2f(mb - mn);
          float p[4];
#pragma unroll
          for (int i = 0; i < 4; ++i) p[i] = __builtin_amdgcn_exp2f(sbv[i] - mn);
          lb = lb * al + (p[0] + p[1]) + (p[2] + p[3]); mb = mn;
#pragma unroll
          for (int e4 = 0; e4 < 4; ++e4) {
            ob[4 * e4] = ob[4 * e4] * al + (p[0] * vv[0][e4].x + p[1] * vv[1][e4].x) + (p[2] * vv[2][e4].x + p[3] * vv[3][e4].x);
            ob[4 * e4 + 1] = ob[4 * e4 + 1] * al + (p[0] * vv[0][e4].y + p[1] * vv[1][e4].y) + (p[2] * vv[2][e4].y + p[3] * vv[3][e4].y);
            ob[4 * e4 + 2] = ob[4 * e4 + 2] * al + (p[0] * vv[0][e4].z + p[1] * vv[1][e4].z) + (p[2] * vv[2][e4].z + p[3] * vv[3][e4].z);
            ob[4 * e4 + 3] = ob[4 * e4 + 3] * al + (p[0] * vv[0][e4].w + p[1] * vv[1][e4].w) + (p[2] * vv[2][e4].w + p[3] * vv[3][e4].w); } }
    }
    __syncthreads();
    LAS float* oL = (LAS float*)lds; LAS f32x2* mlL = (LAS f32x2*)(lds + 65536);
#pragma unroll
    for (int e4 = 0; e4 < 4; ++e4) { *(LAS f32x4*)(oL + w * 1024 + 16 * lane + 4 * e4) = (f32x4){oa[4 * e4], oa[4 * e4 + 1], oa[4 * e4 + 2], oa[4 * e4 + 3]};
                                     *(LAS f32x4*)(oL + 8192 + w * 1024 + 16 * lane + 4 * e4) = (f32x4){ob[4 * e4], ob[4 * e4 + 1], ob[4 * e4 + 2], ob[4 * e4 + 3]}; }
    { f32x2 x; x.x = ma; x.y = la; mlL[w * 64 + lane] = x; x.x = mb; x.y = lb; mlL[512 + w * 64 + lane] = x; }
    __syncthreads();
    if (w == 0 || (w == 1 && pair)) {
        const LAS float* oq = oL + w * 8192; const LAS f32x2* mq = mlL + w * 512; const int task = sb * 8 + (w ? t2 : t);
        float M = -1e30f;
#pragma unroll
        for (int ww = 0; ww < 8; ++ww) M = fmaxf(M, mq[ww * 64 + lane].x);
        float Lsum = 0.f; f32x4 acc[4];
#pragma unroll
        for (int e4 = 0; e4 < 4; ++e4) acc[e4] = (f32x4){0.f, 0.f, 0.f, 0.f};
#pragma unroll
        for (int ww = 0; ww < 8; ++ww) { const f32x2 x = mq[ww * 64 + lane]; const float sc = __builtin_amdgcn_exp2f(x.x - M); Lsum += x.y * sc;
#pragma unroll
            for (int e4 = 0; e4 < 4; ++e4) acc[e4] = acc[e4] + *(const LAS f32x4*)(oq + ww * 1024 + 16 * lane + 4 * e4) * sc; }
        const float inv = (Lsum > 0.f) ? 1.f / Lsum : 0.f; const float lse = (Lsum > 0.f) ? (M + __log2f(Lsum)) * LN2 : -1e30f;
        float* op = F.SO() + ((size_t)(G * 2 + hf) * 256 + task) * 1024 + 16 * lane;
#pragma unroll
        for (int e4 = 0; e4 < 4; ++e4) *(f32x4*)(op + 4 * e4) = acc[e4] * inv;
        if ((lane & 3) == 0) F.SLSE()[((size_t)(G * 2 + hf) * 256 + task) * 16 + h] = lse;
    }
}
__device__ __forceinline__ void attn_sample_combine(Frame& F, int task) {
    int tid_ = F.tid; asm volatile("" : "+v"(tid_));
    const int c = 2 * tid_, h = c >> 6; const size_t qrow = (size_t)MP + task;
    float l[6]; f32x2 a[6]; float mx = -1e30f;
#pragma unroll
    for (int p = 0; p < 6; ++p) { l[p] = F.SLSE()[((size_t)p * 256 + task) * 16 + h]; a[p] = *(const f32x2*)(F.SO() + ((size_t)p * 256 + task) * 1024 + c); }
    const unsigned gw = *(const GAS unsigned*)(F.QS() + (size_t)task * NQKVG + 9216 + c);
#pragma unroll
    for (int p = 0; p < 6; ++p) mx = fmaxf(mx, l[p]);
    float den = 0.f, o0 = 0.f, o1 = 0.f;
#pragma unroll
    for (int p = 0; p < 6; ++p) { const float e = __expf(l[p] - mx); den += e; o0 += a[p].x * e; o1 += a[p].y * e; }
    const float inv = 1.f / den;
    *(GAS unsigned*)(F.Y() + qrow * 1024 + c) = pk2(o0 * inv * silu_f(bflo(gw)), o1 * inv * silu_f(bfhi(gw)));
}

__device__ __forceinline__ void attn_phase(Frame& F, int sub, int j) {
    const int nunit = sub == 0 ? 512 : 256, ngg = sub == 0 ? 2 : 1;
    const bool tasks_first = false;
    for (int pass = 0; pass < 2; ++pass) {
        if ((pass == 0) == tasks_first) {
            if (sub == 0) {
                for (int x = F.vcu; x < 1024; x += F.G) { const int id = x & 511; int g, sb, t, pair, hf;
                    if (x < 512) { const int r = id >> 1, pr = (r >> 1) & 3; g = id & 1; hf = r & 1; sb = r >> 3; t = g ? pr : 2 * pr; pair = 1; }
                    else { const int task = id >> 1; g = 2; hf = id & 1; sb = task >> 3; t = task & 7; pair = 0; }
                    attn_sample_task(F, g, j, sb, t, pair, hf); } }
        } else {
            const int ns = (nunit - F.vcu + F.G - 1) / F.G;
            const int ncall = (sub == 0 && ns < 2) ? 2 : 1;
            for (int cl = 0; cl < ncall; ++cl) { BlkList L; L.sub = sub; L.ns = ns; L.sp0 = F.vcu; L.sps = F.G; L.glo = (ncall == 2) ? cl : 0; L.ghi = (ncall == 2) ? cl + 1 : 2; attn_blocks(F, L); }
        }
    }
    if (sub == 1) for (int task = F.vcu; task < 256; task += F.G) attn_sample_combine(F, task);
}
template <int NT, class Epi>
__device__ __forceinline__ void sgemm_unit(Frame& F, const bf16* A, const bf16* Bt, int K, int n0, const Epi& E) {
    int tid_ = F.tid; asm volatile("" : "+v"(tid_));
    const int lane = tid_ & 63, w = __builtin_amdgcn_readfirstlane(tid_ >> 6), fr = lane & 15, fq = lane >> 4;
    constexpr int STAGE = (256 + 16 * NT) * 128;
    static_assert(3 * STAGE <= RING_BYTES + 16384, "sgemm ring");
    f32x4 acc[2][NT];
#pragma unroll
    for (int m = 0; m < 2; ++m)
#pragma unroll
        for (int nt = 0; nt < NT; ++nt) acc[m][nt] = (f32x4){0.f, 0.f, 0.f, 0.f};
    const int nch = K >> 6;
    const int r8 = lane >> 3, s8 = lane & 7;
    const bf16* asrc[4];
#pragma unroll
    for (int i = 0; i < 4; ++i) { const int row = w * 32 + i * 8 + r8; asrc[i] = A + (size_t)row * K + ((s8 ^ (row & 7)) << 3); }
    const int bp = w % (2 * NT), brow = bp * 8 + r8;
    const bf16* bsrc = Bt + (size_t)(n0 + brow) * K + ((s8 ^ (brow & 7)) << 3);
#define SG_ISSUE(C, SLOT) do { const unsigned sb_ = (unsigned)(size_t)(F.lds + (SLOT) * STAGE); \
        _Pragma("unroll") for (int i = 0; i < 4; ++i) glds16(asrc[i] + (size_t)(C) * 64, sb_ + (unsigned)((w * 32 + i * 8) * 128)); \
        glds16(bsrc + (size_t)(C) * 64, sb_ + 32768u + (unsigned)(bp * 1024)); } while (0)
    __syncthreads();
    SG_ISSUE(0, 0); SG_ISSUE(1, 1);
    int slot = 0;
    for (int c = 0; c < nch; ++c) {
        if (c + 1 < nch) asm volatile("s_waitcnt vmcnt(5)" ::: "memory"); else asm volatile("s_waitcnt vmcnt(0)" ::: "memory");
        asm volatile("s_waitcnt lgkmcnt(0)\n\ts_barrier" ::: "memory");
        if (c + 2 < nch) { const int s2 = (slot + 2 >= 3) ? slot - 1 : slot + 2; SG_ISSUE(c + 2, s2); }
        const LAS unsigned char* sa = F.lds + slot * STAGE; const LAS unsigned char* sbp = sa + 32768;
        bf16x8 af[2][2], bq[NT][2];
#pragma unroll
        for (int m = 0; m < 2; ++m)
#pragma unroll
            for (int ks = 0; ks < 2; ++ks) { const int row = 32 * w + 16 * m + fr; af[m][ks] = *(const LAS bf16x8*)(sa + row * 128 + (((4 * ks + fq) ^ (row & 7)) << 4)); }
#pragma unroll
        for (int nt = 0; nt < NT; ++nt)
#pragma unroll
            for (int ks = 0; ks < 2; ++ks) { const int row = 16 * nt + fr; bq[nt][ks] = *(const LAS bf16x8*)(sbp + row * 128 + (((4 * ks + fq) ^ (row & 7)) << 4)); }
#pragma unroll
        for (int ks = 0; ks < 2; ++ks)
#pragma unroll
            for (int m = 0; m < 2; ++m)
#pragma unroll
                for (int nt = 0; nt < NT; ++nt) acc[m][nt] = __builtin_amdgcn_mfma_f32_16x16x32_bf16(bq[nt][ks], af[m][ks], acc[m][nt], 0, 0, 0);
        slot = (slot == 2) ? 0 : slot + 1;
    }
#undef SG_ISSUE
    typename Epi::Pre pre[2][NT];
#pragma unroll
    for (int m = 0; m < 2; ++m)
#pragma unroll
        for (int nt = 0; nt < NT; ++nt) pre[m][nt] = E.ld(32 * w + 16 * m + fr, n0 + 16 * nt + 4 * fq);
#pragma unroll
    for (int m = 0; m < 2; ++m)
#pragma unroll
        for (int nt = 0; nt < NT; ++nt) E.st(acc[m][nt], pre[m][nt], 32 * w + 16 * m + fr, n0 + 16 * nt + 4 * fq);
    if constexpr (Epi::HAS_FINISH) E.template finish<NT>(acc, w, fr, fq, n0);
}
struct SEpiXg { static constexpr bool HAS_FINISH = false; const Frame& F; int l; bool fused;
    struct Pre { f32x4 sw; float rss; };
    __device__ __forceinline__ Pre ld(int row, int col) const { Pre p; p.sw = (f32x4){0.f, 0.f, 0.f, 0.f}; p.rss = 1024.f;
        if (fused) { p.rss = F.RSS(l)[MP + row]; p.sw = *(const f32x4*)(F.SW(l) + (size_t)(4 + (row >> 3)) * 3072 + col); } return p; }
    __device__ __forceinline__ void st(const f32x4& a, const Pre& p, int row, int col) const { const int nb2 = col / 96, cin = col - nb2 * 96;
        f32x4 v = a; if (fused) v = a * __builtin_amdgcn_rsqf(p.rss * (1.f / 1024.f) + 1e-6f) + p.sw;
        v2u wv; wv.x = pk2(v.x, v.y); wv.y = pk2(v.z, v.w); *(GAS v2u*)(F.XG() + ((size_t)nb2 * MALL + MP + row) * 96 + cin) = wv; } };
struct SEpiResid { static constexpr bool HAS_FINISH = true; const Frame& F; int l; bool hasnext; bool fin;
    struct Pre { f32x4 x, g, gn, sc; };
    __device__ __forceinline__ Pre ld(int row, int col) const { Pre p; const int mr = 4 + (row >> 3);
        const float* xin = (l == 0) ? F.x_sample() : F.XL(l - 1) + (size_t)MP * 1024;
        p.x = *(const f32x4*)(xin + (size_t)row * 1024 + col); p.g = *(const f32x4*)(F.mod() + (size_t)l * 36 * 3072 + 2048 + (size_t)mr * 3072 + col);
        p.gn = p.g; p.sc = p.g;
        if (hasnext) { p.gn = *(const f32x4*)(F.norm_g() + (l + 1) * 1024 + col); p.sc = *(const f32x4*)(F.mod() + (size_t)(l + 1) * 36 * 3072 + 1024 + (size_t)mr * 3072 + col); } return p; }
    __device__ __forceinline__ void st(f32x4& v, const Pre& p, int row, int col) const {
        const f32x4 x = p.x + p.g * v;
        if (fin) { v = x; return; }
        *(f32x4*)(F.XL(l) + (size_t)(MP + row) * 1024 + col) = x;
        if (hasnext) { const f32x4 h = x * p.gn * (p.sc + 1.f);
            v2u wv; wv.x = pk2(h.x, h.y); wv.y = pk2(h.z, h.w); *(GAS v2u*)(F.HN() + (size_t)(MP + row) * 1024 + col) = wv;
            float s = (x.x * x.x + x.y * x.y) + (x.z * x.z + x.w * x.w); const int fq = (col >> 2) & 3, ln = (row & 15) + 16 * fq;
            s += __builtin_bit_cast(float, __builtin_amdgcn_ds_bpermute((ln ^ 16) << 2, __builtin_bit_cast(int, s))); s += __builtin_bit_cast(float, __builtin_amdgcn_ds_bpermute((ln ^ 32) << 2, __builtin_bit_cast(int, s)));
            if (fq == 0) atomicAdd(F.RSS(l + 1) + MP + row, s); } }
    template <int NT> __device__ __forceinline__ void finish(f32x4 (&acc)[2][NT], int w, int fr, int fq, int n0) const {
        if (!fin) return;
        float* rss = F.RSS(0) + MP; const int ln = fr + 16 * fq; float got = 0.f;
        float sm[2];
#pragma unroll
        for (int m = 0; m < 2; ++m) { float s = 0.f;
#pragma unroll
            for (int nt = 0; nt < NT; ++nt) { const f32x4 x = acc[m][nt]; s += (x.x * x.x + x.y * x.y) + (x.z * x.z + x.w * x.w); }
            s += __builtin_bit_cast(float, __builtin_amdgcn_ds_bpermute((ln ^ 16) << 2, __builtin_bit_cast(int, s))); s += __builtin_bit_cast(float, __builtin_amdgcn_ds_bpermute((ln ^ 32) << 2, __builtin_bit_cast(int, s)));
            sm[m] = s; }
        if (fq == 0) { float r0 = atomicAdd(rss + 32 * w + fr, sm[0]), r1 = atomicAdd(rss + 32 * w + 16 + fr, sm[1]); asm volatile("" : "+v"(r0), "+v"(r1)); got = r0; }
        asm volatile("s_waitcnt vmcnt(0)" : "+v"(got) :: "memory");
        gu32* cnt = F.ctl() + CW_FIN + 64 * FIN_STRIDE;
        if (ln == 0) __hip_atomic_fetch_add(cnt, 1u, RLX_AGENT);
        for (int it = 0; it < (1 << 20); ++it) { if (__hip_atomic_load(cnt, RLX_AGENT) >= 128u) break; __builtin_amdgcn_s_sleep(2); }
        float* out = F.out() + OFF_YS; const float* fg = F.final_g();
#pragma unroll
        for (int m = 0; m < 2; ++m) { const int row = 32 * w + 16 * m + fr; const float rs = __builtin_amdgcn_rsqf(__hip_atomic_load(rss + row, RLX_AGENT) * (1.f / 1024.f) + 1e-6f);
#pragma unroll
            for (int nt = 0; nt < NT; ++nt) { const int col = n0 + 16 * nt + 4 * fq; *(f32x4*)(out + (size_t)row * 1024 + col) = acc[m][nt] * rs * *(const f32x4*)(fg + col); } }
    } };
struct SEpiQkv { static constexpr bool HAS_FINISH = false; const Frame& F; int l; int j;
    struct Pre { f32x4 sw; float rss; };
    __device__ __forceinline__ Pre ld(int row, int col) const { Pre p; p.rss = F.RSS(l)[MP + row]; p.sw = *(const f32x4*)(F.SW(l) + (size_t)(4 + (row >> 3)) * 10240 + col); return p; }
    __device__ __forceinline__ void st(const f32x4& a, const Pre& p, int row, int col) const {
        const f32x4 v = a * __builtin_amdgcn_rsqf(p.rss * (1.f / 1024.f) + 1e-6f) + p.sw;
        v2u wv; wv.x = pk2(v.x, v.y); wv.y = pk2(v.z, v.w); *(GAS v2u*)(F.QS() + (size_t)row * NQKVG + col) = wv;
        const int g = col / 3072, part = (col % 3072) / 1024;
        if (g < 3 && part >= 1) { const size_t offs = (g == 0) ? OFF_SKV0 : (g == 1) ? OFF_SKV1 : OFF_SKV2;
            *(f32x4*)(F.out() + offs + ((size_t)(j * 256 + row) * 2 + (part - 1)) * 1024 + (col % 1024)) = v; } } };
struct SEpiSW { static constexpr bool HAS_FINISH = false; float* O; int ldc;
    struct Pre { int dummy; };
    __device__ __forceinline__ Pre ld(int, int) const { Pre p; p.dummy = 0; return p; }
    __device__ __forceinline__ void st(const f32x4& v, const Pre&, int row, int col) const { if (row < 36) *(f32x4*)(O + (size_t)row * ldc + col) = v; } };
__device__ __forceinline__ void flush_caches(Frame& F) {
    const float* src = F.cache2() + (size_t)F.vcu * 524288;
    f32x4 acc = (f32x4){0.f, 0.f, 0.f, 0.f};
    for (int i = F.tid; i < 131072; i += 512) acc = acc + *(const f32x4*)(src + (size_t)i * 4);
    if (acc.x + acc.y + acc.z + acc.w == 12345.678f) F.lse()[0] = acc.x;
}
#ifndef MK_PER_PHASE
#define MK_PER_PHASE 0
#endif
constexpr int NPHASES = 18;
__global__ void __launch_bounds__(NWAVES * 64, 2) fwd_kernel(Args args) {
    extern __shared__ __attribute__((aligned(16))) unsigned char lds[];
    Frame F;
    F.lds = (LAS unsigned char*)lds;
    F.MISC = (volatile LAS unsigned*)(F.lds + MISC_OFF);
    F.tid = threadIdx.x;
    F.G = gridDim.x; { const int bx = blockIdx.x; F.vcu = (F.G % 8 == 0) ? (bx % 8) * (F.G / 8) + bx / 8 : bx; }
    F.A = (const __attribute__((address_space(4))) Args*)__builtin_amdgcn_kernarg_segment_ptr(); F.ws = args.ws; F.sA = 0; F.sO = 0;
    for (int u = F.tid; u < (LDS_BYTES - LDSCTL_OFF) / 4; u += NWAVES * 64) ((LAS unsigned*)(F.lds + LDSCTL_OFF))[u] = 0u;
    __syncthreads();
    const int lo = args.ph_lo, hi = args.ph_hi;
    XcdBarrier bar; bar.bar = (unsigned*)(F.ctl() + CW_BAR); bar.x = 0; bar.st = nullptr;
    if (hi - lo > 1) bar = xcd_barrier_post((unsigned*)(F.ctl() + CW_BAR), F.MISC + 8);
#ifndef PHMASK
#define PHMASK 0xFFF
#endif
#define IN(k) (lo <= (k) && (k) < hi)
#define WAVE_ID() __builtin_amdgcn_readfirstlane(F.tid >> 6)
#define LAUNDER() do { F.A = (const __attribute__((address_space(4))) Args*)(unsigned long long)launder_ptr((const void*)(unsigned long long)F.A); F.ws = (unsigned char*)launder_ptr(F.ws); } while (0)
#ifndef SKIPMASK
#define SKIPMASK 0
#endif
#define EN(b) (((PHMASK >> (b)) & 1) && !(((SKIPMASK >> (b)) & 1) && pass == NPASS - 1 && NPASS > 1 && skipjj))
#ifndef REPMASK
#define REPMASK 0
#endif
#define REP(b) (((REPMASK >> (b)) & 1) ? 2 : 1)
#ifndef FLUSHMASK
#define FLUSHMASK 0
#endif
#define FLUSH(b) do { if ((FLUSHMASK >> (b)) & 1) { XcdBarrier b3 = bar; b3.bar = (unsigned*)launder_ptr(b3.bar); xcd_barrier(b3); flush_caches(F); xcd_barrier(b3); } } while (0)
#define SEAM(k) do { if (IN(k) && IN((k) + 1)) { XcdBarrier b2 = bar; b2.bar = (unsigned*)launder_ptr(b2.bar); xcd_barrier(b2); if (REPMASK & 0x10000) xcd_barrier(b2); } } while (0)

#ifndef NPASS
#define NPASS 1
#endif
    const bool fusef = (F.G >= 256) && IN(16) && IN(17);
    for (int pass = 0; pass < NPASS; ++pass) {
    bool skipjj = true;
    if (pass > 0) { XcdBarrier b2 = bar; b2.bar = (unsigned*)launder_ptr(b2.bar); xcd_barrier(b2);
        for (int i = F.vcu * 512 + F.tid; i < 4 * MALL; i += F.G * 512) F.RSS(0)[i] = 0.f; xcd_barrier(b2); }
    LAUNDER(); if (EN(0) && IN(0)) { _Pragma("nounroll") for (int rep = 0; rep < REP(0); ++rep) { p0_prologue(F); __syncthreads(); } } SEAM(0);
    for (int jj = 0; jj < 2; ++jj) {
        const int pb = 1 + 8 * jj; skipjj = (jj == 1); F.sA = 2 * jj; F.sO = jj;
        const int l0 = 2 * jj, l1 = 2 * jj + 1;
        if (jj == 0) { LAUNDER(); if (EN(1) && IN(pb + 0)) { norm_phase(F, 0); } SEAM(pb + 0); }
        LAUNDER(); if (EN(2) && IN(pb + 1)) {
            pg8::Gemm g{F.H(), F.lwin_t() + (size_t)jj * 3072 * 1024, MP, 3072, 1024}; pg8::StaticOrder S; S.init(MP, 3072, F.G, (int)blockIdx.x);
            pg8::EpiXg E{F, l0, jj != 0, MALL};
            pg8::gemm_phase<pg8::EpiXg, pg8::StaticOrder, true, true>(F.lds + RING_OFF, g, S, E);
            const SEpiXg SE{F, l0, jj != 0};
            for (int u = F.vcu; u < 48; u += F.G) sgemm_unit<4>(F, F.H() + (size_t)MP * 1024, F.lwin_t() + (size_t)jj * 3072 * 1024, 1024, 64 * u, SE);
            if (F.vcu >= 48) conv_items(F, jj, CV_LIN, CV_AIN, F.vcu - 48, F.G - 48);
        } SEAM(pb + 1);
        LAUNDER(); if (EN(4) && IN(pb + 2)) { scan_phase(F, jj); __syncthreads(); } SEAM(pb + 2);
        LAUNDER(); if (EN(5) && IN(pb + 3)) {
            pg8::Gemm g{F.Y(), F.lwout_t() + (size_t)jj * 1024 * 1536, MP, 1024, 1536}; pg8::StaticOrder S; S.init(MP, 1024, F.G, (int)blockIdx.x);
            pg8::EpiResid E{F, l0, true};
            pg8::gemm_phase<pg8::EpiResid, pg8::StaticOrder, true, true>(F.lds + RING_OFF, g, S, E);
            const SEpiResid SE{F, l0, true, false};
            for (int u = F.vcu; u < 16; u += F.G) sgemm_unit<4>(F, F.Y() + (size_t)MP * 1536, F.lwout_t() + (size_t)jj * 1024 * 1536, 1536, 64 * u, SE);
            const SEpiSW SW1{F.SW(l1), 10240};
            for (int u = F.vcu - 16; u >= 0 && u < 160; u += F.G) sgemm_unit<4>(F, F.SHB(l1), F.awin_t() + (size_t)jj * 10240 * 1024, 1024, 64 * u, SW1);
        } SEAM(pb + 3);
        F.sA = 2 * jj + 1;
        LAUNDER(); if (EN(6) && IN(pb + 4)) {
            pg8::Gemm g{F.H(), F.awin_t() + (size_t)jj * 10240 * 1024, MP, 10240, 1024}; pg8::StaticOrder S; S.init(MP, 10240, F.G, (int)blockIdx.x);
            pg8::EpiQkv E{F, l1, jj};
            pg8::gemm_phase<pg8::EpiQkv, pg8::StaticOrder, true, true>(F.lds + RING_OFF, g, S, E);
            const SEpiQkv SE{F, l1, jj};
            for (int u = F.vcu; u < 160; u += F.G) sgemm_unit<4>(F, F.H() + (size_t)MP * 1024, F.awin_t() + (size_t)jj * 10240 * 1024, 1024, 64 * u, SE);
            if (F.vcu >= 160) { conv_items(F, jj, CV_AIN, CV_AOUT, F.vcu - 160, F.G - 160);
                if (jj == 0) conv_items(F, 1, 0, CV_LIN, F.vcu - 160, F.G - 160); }
        } SEAM(pb + 4);
        _Pragma("nounroll") for (int sub = 0; sub < 2; ++sub) {
            LAUNDER(); if (EN(7) && IN(pb + 5 + sub)) { attn_phase(F, sub, jj); if (sub == 1) __syncthreads(); } SEAM(pb + 5 + sub);
        }
        LAUNDER(); if (EN(10) && IN(pb + 7)) {
            pg8::Gemm g{F.Y(), F.awout_t() + (size_t)jj * 1024 * 1024, MP, 1024, 1024}; pg8::StaticOrder S; S.init(MP, 1024, F.G, (int)blockIdx.x);
            if (jj == 1 && fusef) { pg8::EpiFinal E{F, l1}; pg8::gemm_phase<pg8::EpiFinal, pg8::StaticOrder, true, true>(F.lds + RING_OFF, g, S, E); }
            else { pg8::EpiResid E{F, l1, jj == 0}; pg8::gemm_phase<pg8::EpiResid, pg8::StaticOrder, true, true>(F.lds + RING_OFF, g, S, E); }
            const SEpiResid SE{F, l1, jj == 0, jj == 1 && fusef};
            for (int u = F.vcu; u < 16; u += F.G) sgemm_unit<4>(F, F.Y() + (size_t)MP * 1024, F.awout_t() + (size_t)jj * 1024 * 1024, 1024, 64 * u, SE);
            const SEpiSW SW2{F.SW(2), 3072};
            if (jj == 0) for (int u = F.vcu - 16; u >= 0 && u < 48; u += F.G) sgemm_unit<4>(F, F.SHB(2), F.lwin_t() + (size_t)3072 * 1024, 1024, 64 * u, SW2);
        } if (!(jj == 1 && fusef)) SEAM(pb + 7);
    }
    skipjj = true;
    LAUNDER(); if (EN(11) && IN(17) && !fusef) { _Pragma("nounroll") for (int rep = 0; rep < REP(11); ++rep) final_phase(F); }
    FLUSH(12);
    }
#undef IN
#undef WAVE_ID
#undef LAUNDER
#undef EN
#undef REP
#undef FLUSH
#undef SEAM
}

extern "C" void kernel_launch(void* const* d_in, const int* in_sizes, int n_in, void* d_out, int out_size, void* d_ws, size_t ws_size, hipStream_t stream) {
    static int grid = 0;
    if (grid == 0) {
        if (n_in != 24 || out_size != (int)OUT_TOTAL || ws_size < WS_END) { fprintf(stderr, "kernel_launch: unexpected shapes: n_in %d out %d ws %zu; nothing launched\n", n_in, out_size, ws_size); grid = -1; return; }
        int dev = 0, cus = 0, per_cu = 0;
        if (hipGetDevice(&dev) != hipSuccess || hipDeviceGetAttribute(&cus, hipDeviceAttributeMultiprocessorCount, dev) != hipSuccess) { fprintf(stderr, "kernel_launch: device query failed\n"); grid = -1; return; }
        if (hipFuncSetAttribute((const void*)fwd_kernel, hipFuncAttributeMaxDynamicSharedMemorySize, LDS_BYTES) != hipSuccess) { fprintf(stderr, "kernel_launch: hipFuncSetAttribute failed\n"); grid = -1; return; }
        if (hipOccupancyMaxActiveBlocksPerMultiprocessor(&per_cu, (const void*)fwd_kernel, NWAVES * 64, LDS_BYTES) != hipSuccess || per_cu < 1)
            fprintf(stderr, "kernel_launch: note: occupancy query reports %d workgroups per CU\n", per_cu);
        (void)hipGetLastError();
        grid = cus;
    }
    if (grid < 0) return;
    if (hipMemsetAsync((char*)d_ws + WS_CARRY, 0, CARRY_BYTES, stream) != hipSuccess || hipMemsetAsync((char*)d_ws + WS_CTL, 0, CTL_ZERO_BYTES, stream) != hipSuccess) { fprintf(stderr, "kernel_launch: memset failed\n"); return; }
    Args a{};
    for (int i = 0; i < 24; ++i) a.in[i] = (const float*)d_in[i];
    a.outp = (float*)d_out; a.ws = (unsigned char*)d_ws;
#if MK_PER_PHASE
    for (int p = 0; p < NPHASES; ++p) { a.ph_lo = p; a.ph_hi = p + 1; hipLaunchKernelGGL(fwd_kernel, dim3(grid), dim3(NWAVES * 64), LDS_BYTES, stream, a); }
#else
    a.ph_lo = 0; a.ph_hi = NPHASES;
    hipLaunchKernelGGL(fwd_kernel, dim3(grid), dim3(NWAVES * 64), LDS_BYTES, stream, a);
#endif
    const hipError_t le = hipPeekAtLastError();
    if (le != hipSuccess) fprintf(stderr, "kernel_launch: launch failed: %s\n", hipGetErrorName(le));
}
```
